# Optimizing an MI355X kernel written in HIP

```python
import jax, jax.numpy as jnp
from jax import lax
import numpy as np

D_MODEL = 1024
BATCH = 4
SEQ = 8192
DEPTH = 4

HEAD_DIM = 128
A_GROUPS = 4
A_GROUP_DIM = 128
A_WIDTH = A_GROUPS * A_GROUP_DIM
CHUNK = 128
NSA_HEADS = 8
NSA_KV_GROUPS = 2
NSA_WIDTH = NSA_HEADS * HEAD_DIM
NSA_KV_WIDTH = 3 * 2 * NSA_KV_GROUPS * HEAD_DIM
CMP_BLOCK = 32
CMP_STRIDE = 16
SLC_BLOCK = 64
N_SELECT = 16
WINDOW = 512
Q_BLOCK = 32
MEM_TOKENS = 256
MEM_HEADS = 4
MEM_WIDTH = MEM_HEADS * HEAD_DIM
ROPE_DIM = HEAD_DIM // 4
ROPE_THETA = 500000.0
EPS = 1e-6
NEG_INF = -1e30
FORCED_SCORE = 1e4
IN_SIZES = (A_WIDTH, A_WIDTH, A_WIDTH,
            NSA_WIDTH, NSA_WIDTH, NSA_HEADS * 3, NSA_KV_WIDTH,
            MEM_WIDTH, MEM_WIDTH,
            3 * D_MODEL)
D_IN = sum(IN_SIZES)

kernel_name = "hybrid_gmlp_nsa_memory_block"


def rmsnorm(x, gain):
    x32 = x.astype(jnp.float32)
    y = x32 * lax.rsqrt(jnp.mean(x32 * x32, axis=-1, keepdims=True) + EPS)
    return (y * gain.astype(jnp.float32)).astype(x.dtype)


def layernorm(x, gain, bias):
    x32 = x.astype(jnp.float32)
    xc = x32 - jnp.mean(x32, axis=-1, keepdims=True)
    y = xc * lax.rsqrt(jnp.mean(xc * xc, axis=-1, keepdims=True) + EPS)
    return (y * gain.astype(jnp.float32) + bias.astype(jnp.float32)).astype(x.dtype)


def rope_tables(positions):
    inv_freq = ROPE_THETA ** (-jnp.arange(0, ROPE_DIM, 2, dtype=jnp.float32) / ROPE_DIM)
    ang = positions.astype(jnp.float32)[..., None] * inv_freq
    return jnp.cos(ang)[:, :, None, :], jnp.sin(ang)[:, :, None, :]


def apply_partial_rope(t, cos, sin):
    half = ROPE_DIM // 2
    t1 = t[..., :half].astype(jnp.float32)
    t2 = t[..., half:ROPE_DIM].astype(jnp.float32)
    rot = jnp.concatenate([t1 * cos - t2 * sin, t2 * cos + t1 * sin], axis=-1).astype(t.dtype)
    return jnp.concatenate([rot, t[..., ROPE_DIM:]], axis=-1)


def chunk_spatial_gating(u, v, ln_g, ln_b, w_s, b_s):
    B, S, _ = v.shape
    vn = layernorm(v, ln_g, ln_b).reshape(B, S // CHUNK, CHUNK, A_GROUPS, A_GROUP_DIM)
    ws = w_s * jnp.tril(jnp.ones((CHUNK, CHUNK), w_s.dtype))
    mixed = jnp.einsum('gts,bnsgc->bntgc', ws, vn) + b_s.T[:, :, None]
    return u * mixed.reshape(B, S, A_WIDTH)


def compress_blocks(t, pe, w1, w2):
    B, S, G, Dh = t.shape
    tb = t.reshape(B, S // CMP_STRIDE, CMP_STRIDE, G, Dh)
    blocks = jnp.concatenate([tb[:, :-1], tb[:, 1:]], axis=2) + pe[:, None, :]
    h = jax.nn.silu(jnp.einsum('bnlgd,ldh->bngh', blocks, w1))
    return jnp.einsum('bngh,hd->bngd', h, w2)


def cmp_to_slc_matrix(n_cmp, n_slc):
    i = np.arange(n_cmp)[:, None] * CMP_STRIDE
    j = np.arange(n_slc)[None, :] * SLC_BLOCK
    ov = np.clip(np.minimum(i + CMP_BLOCK, j + SLC_BLOCK) - np.maximum(i, j), 0, None)
    return jnp.asarray(ov / CMP_BLOCK, dtype=jnp.float32)


def nsa_attention(q, k_cmp, v_cmp, k_slc, v_slc, k_win, v_win, gates):
    B, S, H, Dh = q.shape
    G = NSA_KV_GROUPS
    R = H // G
    n_cmp = k_cmp.shape[1]
    n_slc = S // SLC_BLOCK
    n_sel = min(N_SELECT, n_slc)
    nb = S // Q_BLOCK
    scale = Dh ** -0.5
    cmp_end = jnp.arange(n_cmp) * CMP_STRIDE + (CMP_BLOCK - 1)
    m_cs = cmp_to_slc_matrix(n_cmp, n_slc)
    ks_blk = k_slc.reshape(B, n_slc, SLC_BLOCK, G, Dh).transpose(0, 3, 1, 2, 4)
    vs_blk = v_slc.reshape(B, n_slc, SLC_BLOCK, G, Dh).transpose(0, 3, 1, 2, 4)
    kw_pad = jnp.pad(k_win, ((0, 0), (WINDOW, 0), (0, 0), (0, 0)))
    vw_pad = jnp.pad(v_win, ((0, 0), (WINDOW, 0), (0, 0), (0, 0)))
    b_ix = jnp.arange(B)[:, None, None, None]
    g_ix = jnp.arange(G)[None, None, :, None]
    slc_off = jnp.arange(SLC_BLOCK)
    blk_ids = jnp.arange(n_slc)

    def one_block(args):
        qb, gb, blk = args
        s0 = blk * Q_BLOCK
        t = s0 + jnp.arange(Q_BLOCK)
        sc = jnp.einsum('btgrd,bngd->bgrtn', qb, k_cmp).astype(jnp.float32) * scale
        cmask = cmp_end[None, :] <= t[:, None]
        pc = jax.nn.softmax(jnp.where(cmask, sc, NEG_INF), axis=-1) * cmask
        o_cmp = jnp.einsum('bgrtn,bngd->btgrd', pc.astype(qb.dtype), v_cmp)
        imp = jnp.einsum('bgrtn,nj->btgj', pc, m_cs)
        cur = (t // SLC_BLOCK)[None, :, None, None]
        forced = (blk_ids == 0) | (blk_ids == cur) | (blk_ids == cur - 1)
        imp = jnp.where(forced, FORCED_SCORE, jnp.where(blk_ids <= cur, imp, -1.0))
        _, idx = lax.top_k(imp, n_sel)
        kg = ks_blk[b_ix, g_ix, idx]
        vg = vs_blk[b_ix, g_ix, idx]
        ss = jnp.einsum('btgrd,btgkld->btgrkl', qb, kg).astype(jnp.float32) * scale
        tok = idx[..., None] * SLC_BLOCK + slc_off
        smask = (tok <= t[None, :, None, None, None])[:, :, :, None]
        ss = jnp.where(smask, ss, NEG_INF)
        ps = jax.nn.softmax(ss.reshape(B, Q_BLOCK, G, R, -1), axis=-1).reshape(ss.shape)
        o_slc = jnp.einsum('btgrkl,btgkld->btgrd', ps.astype(qb.dtype), vg)
        kw = lax.dynamic_slice_in_dim(kw_pad, s0, Q_BLOCK + WINDOW, axis=1)
        vw = lax.dynamic_slice_in_dim(vw_pad, s0, Q_BLOCK + WINDOW, axis=1)
        kpos = s0 - WINDOW + jnp.arange(Q_BLOCK + WINDOW)
        rel = t[:, None] - kpos[None, :]
        wmask = (rel >= 0) & (rel < WINDOW) & (kpos[None, :] >= 0)
        sw = jnp.einsum('btgrd,bsgd->bgrts', qb, kw).astype(jnp.float32) * scale
        pw = jax.nn.softmax(jnp.where(wmask, sw, NEG_INF), axis=-1)
        o_win = jnp.einsum('bgrts,bsgd->btgrd', pw.astype(qb.dtype), vw)
        gb = gb.reshape(B, Q_BLOCK, G, R, 3)
        return gb[..., 0:1] * o_cmp + gb[..., 1:2] * o_slc + gb[..., 2:3] * o_win

    q_blocks = q.reshape(B, nb, Q_BLOCK, G, R, Dh).transpose(1, 0, 2, 3, 4, 5)
    g_blocks = gates.reshape(B, nb, Q_BLOCK, H, 3).transpose(1, 0, 2, 3, 4)
    out = lax.map(one_block, (q_blocks, g_blocks, jnp.arange(nb)))
    return out.transpose(1, 0, 2, 3, 4, 5).reshape(B, S, H * Dh)


def memory_attention(q, k, v):
    B, S, H, Dh = q.shape
    s = jnp.einsum('bshd,bmhd->bhsm', q, k).astype(jnp.float32) * (Dh ** -0.5)
    p = jax.nn.softmax(s, axis=-1)
    return jnp.einsum('bhsm,bmhd->bshd', p.astype(q.dtype), v).reshape(B, S, H * Dh)


def setup_inputs(seed: int = 0) -> dict:
    key = jax.random.key(seed)
    ks = jax.random.split(key, 24)
    f32 = jnp.float32

    def nrm(k, shape, scale):
        return jax.random.normal(k, shape, f32) * scale

    x = nrm(ks[0], (BATCH, SEQ, D_MODEL), 1.0)
    mem = nrm(ks[1], (BATCH, MEM_TOKENS, D_MODEL), 1.0)
    offsets = jax.random.randint(ks[2], (BATCH, 1), 0, 4096, dtype=jnp.int32)
    positions = offsets + jnp.arange(SEQ, dtype=jnp.int32)[None, :]
    return {
        "x": x,
        "mem": mem,
        "positions": positions,
        "norm_gain": 1.0 + nrm(ks[3], (DEPTH, D_MODEL), 0.05),
        "w_in": nrm(ks[4], (DEPTH, D_MODEL, D_IN), D_MODEL ** -0.5),
        "ln_v_gain": 1.0 + nrm(ks[5], (DEPTH, A_WIDTH), 0.05),
        "ln_v_bias": nrm(ks[6], (DEPTH, A_WIDTH), 0.02),
        "w_spatial": nrm(ks[7], (DEPTH, A_GROUPS, CHUNK, CHUNK), 0.5 * CHUNK ** -0.5),
        "b_spatial": 1.0 + nrm(ks[8], (DEPTH, A_GROUPS, CHUNK), 0.1),
        "cmp_pe_k": nrm(ks[9], (DEPTH, CMP_BLOCK, HEAD_DIM), 0.1),
        "cmp_w1_k": nrm(ks[10], (DEPTH, CMP_BLOCK, HEAD_DIM, HEAD_DIM), (CMP_BLOCK * HEAD_DIM) ** -0.5),
        "cmp_w2_k": nrm(ks[11], (DEPTH, HEAD_DIM, HEAD_DIM), HEAD_DIM ** -0.5),
        "cmp_pe_v": nrm(ks[12], (DEPTH, CMP_BLOCK, HEAD_DIM), 0.1),
        "cmp_w1_v": nrm(ks[13], (DEPTH, CMP_BLOCK, HEAD_DIM, HEAD_DIM), (CMP_BLOCK * HEAD_DIM) ** -0.5),
        "cmp_w2_v": nrm(ks[14], (DEPTH, HEAD_DIM, HEAD_DIM), HEAD_DIM ** -0.5),
        "mem_norm_gain": 1.0 + nrm(ks[15], (D_MODEL,), 0.05),
        "w_mem_kv": nrm(ks[16], (DEPTH, D_MODEL, 2 * MEM_WIDTH), D_MODEL ** -0.5),
        "w_branch_a": nrm(ks[17], (DEPTH, A_WIDTH, D_MODEL), A_WIDTH ** -0.5),
        "w_branch_b": nrm(ks[18], (DEPTH, NSA_WIDTH, D_MODEL), NSA_WIDTH ** -0.5),
        "w_branch_c": nrm(ks[19], (DEPTH, MEM_WIDTH, D_MODEL), MEM_WIDTH ** -0.5),
        "w_out": nrm(ks[20], (DEPTH, D_MODEL, D_MODEL), D_MODEL ** -0.5),
        "final_norm_gain": 1.0 + nrm(ks[21], (D_MODEL,), 0.05),
    }


def reference(x, mem, positions, norm_gain, w_in, ln_v_gain, ln_v_bias, w_spatial, b_spatial,
              cmp_pe_k, cmp_w1_k, cmp_w2_k, cmp_pe_v, cmp_w1_v, cmp_w2_v, mem_norm_gain, w_mem_kv,
              w_branch_a, w_branch_b, w_branch_c, w_out, final_norm_gain):
    B, S, D = x.shape
    G = NSA_KV_GROUPS
    splits = [int(s) for s in np.cumsum(IN_SIZES)[:-1]]
    cos, sin = rope_tables(positions)
    mem_n = rmsnorm(mem, mem_norm_gain)
    for l in range(DEPTH):
        h = rmsnorm(x, norm_gain[l])
        proj = h @ w_in[l]
        a_u, a_v, a_z, b_q, b_z, b_g, b_kv, c_q, c_z, merge = jnp.split(proj, splits, axis=-1)
        o_a = chunk_spatial_gating(a_u, a_v, ln_v_gain[l], ln_v_bias[l], w_spatial[l], b_spatial[l])
        o_a = o_a * jax.nn.silu(a_z)
        q = apply_partial_rope(b_q.reshape(B, S, NSA_HEADS, HEAD_DIM), cos, sin)
        kv = b_kv.reshape(B, S, 3, 2, G, HEAD_DIM)
        k_cmp = compress_blocks(apply_partial_rope(kv[:, :, 0, 0], cos, sin), cmp_pe_k[l], cmp_w1_k[l], cmp_w2_k[l])
        v_cmp = compress_blocks(kv[:, :, 0, 1], cmp_pe_v[l], cmp_w1_v[l], cmp_w2_v[l])
        k_slc = apply_partial_rope(kv[:, :, 1, 0], cos, sin)
        k_win = apply_partial_rope(kv[:, :, 2, 0], cos, sin)
        gates = jax.nn.sigmoid(b_g).reshape(B, S, NSA_HEADS, 3)
        o_b = nsa_attention(q, k_cmp, v_cmp, k_slc, kv[:, :, 1, 1], k_win, kv[:, :, 2, 1], gates)
        o_b = o_b * jax.nn.silu(b_z)
        mkv = (mem_n @ w_mem_kv[l]).reshape(B, MEM_TOKENS, 2, MEM_HEADS, HEAD_DIM)
        o_c = memory_attention(c_q.reshape(B, S, MEM_HEADS, HEAD_DIM), mkv[:, :, 0], mkv[:, :, 1])
        o_c = o_c * jax.nn.silu(c_z)
        g = jax.nn.sigmoid(merge).reshape(B, S, 3, D)
        mixed = (g[:, :, 0] * (o_a @ w_branch_a[l]) + g[:, :, 1] * (o_b @ w_branch_b[l])
                 + g[:, :, 2] * (o_c @ w_branch_c[l]))
        x = x + mixed @ w_out[l]
    return rmsnorm(x, final_norm_gain)
```

```cpp
#include <hip/hip_runtime.h>
#include <hip/hip_cooperative_groups.h>
#include <stdint.h>
#include <cstdio>
namespace cg = cooperative_groups;

typedef unsigned short u16;
using bf16x8 = __attribute__((ext_vector_type(8))) short;
using s16x4  = __attribute__((ext_vector_type(4))) short;
using f32x4  = __attribute__((ext_vector_type(4))) float;
using u32x4  = __attribute__((ext_vector_type(4))) unsigned;
#define DI __device__ __forceinline__
#define MFMA16(a, b, c) __builtin_amdgcn_mfma_f32_16x16x32_bf16((a), (b), (c), 0, 0, 0)

constexpr int DM = 1024;
constexpr int NBATCH = 4;
constexpr int S = 8192;
constexpr int DEPTH = 4;
constexpr int NP = 9344;
constexpr int DIN = 9240;
constexpr int C_AU = 0, C_AV = 512, C_AZ = 1024, C_BQ = 1536, C_BZ = 2560;
constexpr int C_KV = 3584;
constexpr int C_CQ = 5120, C_CZ = 5632, C_MG = 6144, C_BG = 9216;

constexpr size_t MB = 1u << 20;
constexpr size_t SZ_WIN = (size_t)NP * 1024 * 2;
constexpr size_t LW_WIN = 0;
constexpr size_t LW_WA = LW_WIN + SZ_WIN;
constexpr size_t LW_WB = LW_WA + 1 * MB;
constexpr size_t LW_WC = LW_WB + 2 * MB;
constexpr size_t LW_WO = LW_WC + 1 * MB;
constexpr size_t LW_WMKV = LW_WO + 2 * MB;
constexpr size_t LW_W1K = LW_WMKV + 2 * MB;
constexpr size_t LW_W1V = LW_W1K + 1 * MB;
constexpr size_t LW_W2K = LW_W1V + 1 * MB;
constexpr size_t LW_W2V = LW_W2K + 32768;
constexpr size_t LW_WSP = LW_W2V + 32768;
constexpr size_t LW_SIZE = LW_WSP + 131072;
constexpr size_t OFF_MEMN = LW_SIZE * DEPTH;
constexpr size_t OFF_MK = OFF_MEMN + 2 * MB;
constexpr size_t OFF_MVT = OFF_MK + 4 * MB;
constexpr size_t OFF_ROPE = OFF_MVT + 4 * MB;
constexpr size_t OFF_H = OFF_ROPE + 4 * MB;
constexpr size_t OFF_PROJ = OFF_H + 16 * MB;
constexpr size_t SZ_PROJ = (size_t)S * NP * 2;
constexpr size_t OFF_VTS = OFF_PROJ + SZ_PROJ;
constexpr size_t OFF_VTW = OFF_VTS + 4 * MB;
constexpr size_t OFF_KS = OFF_VTW + 4 * MB;
constexpr size_t OFF_KW = OFF_KS + 4 * MB;
constexpr size_t OFF_KCMP = OFF_KW + 4 * MB;
constexpr size_t OFF_VCMPT = OFF_KCMP + 262144;
constexpr size_t OFF_OA = OFF_VCMPT + 262144;
constexpr size_t OFF_OB = OFF_OA + 8 * MB;
constexpr size_t OFF_OC = OFF_OB + 16 * MB;
constexpr size_t OFF_MIX = OFF_OC + 8 * MB;
constexpr size_t OFF_BAR = OFF_MIX + 16 * MB;
constexpr size_t OFF_TOT = OFF_BAR + 16384;
constexpr size_t WS_TOTAL = OFF_TOT + 16 * MB;

struct Params {
  const float* x; const float* mem; const int* pos;
  const float* norm_gain; const float* w_in; const float* ln_g; const float* ln_b;
  const float* w_sp; const float* b_sp;
  const float* pe_k; const float* w1_k; const float* w2_k;
  const float* pe_v; const float* w1_v; const float* w2_v;
  const float* mem_gain; const float* w_memkv;
  const float* w_a; const float* w_b; const float* w_c; const float* w_out; const float* fin_gain;
  float* out; char* ws;
};

DI u16 f2bf(float x) { unsigned u = __float_as_uint(x); u += 0x7fffu + ((u >> 16) & 1u); return (u16)(u >> 16); }
DI float bf2f(u16 h) { return __uint_as_float(((unsigned)h) << 16); }
DI float bf2f_s(short h) { return __uint_as_float(((unsigned)(u16)h) << 16); }
DI float wave_sum(float v) {
#pragma unroll
  for (int o = 32; o > 0; o >>= 1) v += __shfl_xor(v, o);
  return v;
}
DI float sigmoidf_(float x) { return 1.f / (1.f + __expf(-x)); }
DI float siluf_(float x) { return x / (1.f + __expf(-x)); }
using u32x2 = __attribute__((ext_vector_type(2))) unsigned;
DI s16x4 pack4(const f32x4& v) {
  u32x2 r;
  asm("v_cvt_pk_bf16_f32 %0, %2, %3\n\tv_cvt_pk_bf16_f32 %1, %4, %5" : "=&v"(r[0]), "=&v"(r[1]) : "v"(v[0]), "v"(v[1]), "v"(v[2]), "v"(v[3]));
  return __builtin_bit_cast(s16x4, r);
}
DI bf16x8 pack8(const float (&p)[8]) {
  u32x4 r;
  asm volatile("v_cvt_pk_bf16_f32 %0, %4, %5\n\tv_cvt_pk_bf16_f32 %1, %6, %7\n\tv_cvt_pk_bf16_f32 %2, %8, %9\n\tv_cvt_pk_bf16_f32 %3, %10, %11\n\ts_nop 1"
               : "=&v"(r[0]), "=&v"(r[1]), "=&v"(r[2]), "=&v"(r[3])
               : "v"(p[0]), "v"(p[1]), "v"(p[2]), "v"(p[3]), "v"(p[4]), "v"(p[5]), "v"(p[6]), "v"(p[7]));
  return __builtin_bit_cast(bf16x8, r);
}
DI float fexp2(float x) { return __builtin_amdgcn_exp2f(x); }
DI bf16x8 cat8(const s16x4& a, const s16x4& b) { return __builtin_shufflevector(a, b, 0, 1, 2, 3, 4, 5, 6, 7); }
DI int otid() { int t = threadIdx.x; asm volatile("" : "+v"(t)); return t; }
DI f32x4 zero4() { f32x4 z = {0.f, 0.f, 0.f, 0.f}; return z; }

DI int offK(int key, int d) { return (key >> 4) * 2048 + (d >> 5) * 512 + ((((d & 31) >> 3) * 16 + (key & 15)) * 8) + (d & 7); }
DI int offV(int key, int d) { return (key >> 5) * 4096 + (d >> 4) * 512 + (((key & 31) >> 4) * 256) + ((((key & 15) >> 2) * 16 + (d & 15)) * 4) + (key & 3); }

DI int win_col(int n) { return n < 3584 ? n : (n < 9216 ? n + 24 : (n < 9240 ? n - 9216 + 3584 : -1)); }
DI void transpose_tile(const float* __restrict__ src, int ldsrc, int K, u16* __restrict__ dst, int n0, int k0, bool winmode, u16* lds) {
  const int t = otid();
  constexpr int TS = 68;
  __syncthreads();
  {
    const int kk = t >> 4, n4 = (t & 15) * 4;
    const int n = n0 + n4;
    const int col = winmode ? win_col(n) : n;
#pragma unroll
    for (int h = 0; h < 2; ++h) {
      f32x4 v = zero4();
      if (col >= 0) v = *(const f32x4*)(src + (size_t)(k0 + kk + 32 * h) * ldsrc + col);
      *(s16x4*)(lds + (kk + 32 * h) * TS + n4) = pack4(v);
    }
  }
  __syncthreads();
  {
    const int n = t >> 3, k8 = (t & 7) * 8;
    bf16x8 o;
#pragma unroll
    for (int j = 0; j < 8; ++j) o[j] = (short)lds[(k8 + j) * TS + n];
    *(bf16x8*)(dst + (size_t)(n0 + n) * K + k0 + k8) = o;
  }
}

DI void rmsnorm_row_bf16(const float* __restrict__ x, const float* __restrict__ gain, u16* __restrict__ dst) {
  const int lane = otid() & 63;
  float4 v[4]; float ss = 0.f;
#pragma unroll
  for (int i = 0; i < 4; ++i) { v[i] = *(const float4*)(x + i * 256 + lane * 4); ss += v[i].x * v[i].x + v[i].y * v[i].y + v[i].z * v[i].z + v[i].w * v[i].w; }
  ss = wave_sum(ss);
  const float r = rsqrtf(ss * (1.f / 1024.f) + 1e-6f);
#pragma unroll
  for (int i = 0; i < 4; ++i) {
    float4 g = *(const float4*)(gain + i * 256 + lane * 4);
    s16x4 o; o[0] = (short)f2bf(v[i].x * r * g.x); o[1] = (short)f2bf(v[i].y * r * g.y); o[2] = (short)f2bf(v[i].z * r * g.z); o[3] = (short)f2bf(v[i].w * r * g.w);
    *(s16x4*)(dst + i * 256 + lane * 4) = o;
  }
}

constexpr int LDSS = 64;
template <int NF, bool WIN = false>
DI void gemm_mainloop(const u16* __restrict__ A, int lda, const u16* __restrict__ Bt, int ldb, int K, f32x4 (&acc)[4][NF], u16* sA, u16* sB, const float* __restrict__ pe = nullptr) {
  constexpr int GEMM_BUF = 384 * LDSS;
  const int tid = otid(), lane = tid & 63, wave = tid >> 6;
  const int wm = wave >> 1, wn = wave & 1, fr = lane & 15, fq = lane >> 4;
  u32x4 xa[4], xb[NF / 2], ya[4], yb[NF / 2];
  const int lrow = tid >> 3, lkc = (tid & 7) * 8;
  auto gload = [&](u32x4 (&ra)[4], u32x4 (&rb)[NF / 2], int k0) {
#pragma unroll
    for (int i = 0; i < 4; ++i) ra[i] = *(const u32x4*)(A + (size_t)(lrow + 64 * i) * lda + (WIN ? (size_t)(k0 >> 7) * NP + (k0 & 127) : (size_t)k0) + lkc);
#pragma unroll
    for (int i = 0; i < NF / 2; ++i) rb[i] = *(const u32x4*)(Bt + (size_t)(lrow + 64 * i) * ldb + k0 + lkc);
  };
  auto lwrite = [&](u32x4 (&ra)[4], u32x4 (&rb)[NF / 2], int k0, int buf) {
    if (WIN) {
      const float* pp = pe + (k0 >> 7) * 128 + (k0 & 127) + lkc;
      const f32x4 q0 = *(const f32x4*)pp, q1 = *(const f32x4*)(pp + 4);
#pragma unroll
      for (int i = 0; i < 4; ++i) {
        u32x4 w;
        w[0] = (unsigned)f2bf(__uint_as_float(ra[i][0] << 16) + q0[0]) | ((unsigned)f2bf(__uint_as_float(ra[i][0] & 0xffff0000u) + q0[1]) << 16);
        w[1] = (unsigned)f2bf(__uint_as_float(ra[i][1] << 16) + q0[2]) | ((unsigned)f2bf(__uint_as_float(ra[i][1] & 0xffff0000u) + q0[3]) << 16);
        w[2] = (unsigned)f2bf(__uint_as_float(ra[i][2] << 16) + q1[0]) | ((unsigned)f2bf(__uint_as_float(ra[i][2] & 0xffff0000u) + q1[1]) << 16);
        w[3] = (unsigned)f2bf(__uint_as_float(ra[i][3] << 16) + q1[2]) | ((unsigned)f2bf(__uint_as_float(ra[i][3] & 0xffff0000u) + q1[3]) << 16);
        ra[i] = w;
      }
    }
    u16* nA = sA + buf * GEMM_BUF;
    u16* nB = sB + buf * GEMM_BUF;
#pragma unroll
    for (int i = 0; i < 4; ++i) *(u32x4*)(nA + (lrow + 64 * i) * LDSS + (((lkc >> 3) ^ ((lrow >> 1) & 7)) << 3)) = ra[i];
#pragma unroll
    for (int i = 0; i < NF / 2; ++i) *(u32x4*)(nB + (lrow + 64 * i) * LDSS + (((lkc >> 3) ^ ((lrow >> 1) & 7)) << 3)) = rb[i];
  };
  auto compute = [&](int buf) {
    const u16* cA = sA + buf * GEMM_BUF;
    const u16* cB = sB + buf * GEMM_BUF;
    bf16x8 af0[4], bf0[NF], af1[4], bf1[NF];
    const int rs0 = ((fq ^ ((fr >> 1) & 7)) << 3), rs1 = (((4 + fq) ^ ((fr >> 1) & 7)) << 3);
#pragma unroll
    for (int m = 0; m < 4; ++m) af0[m] = *(const bf16x8*)(cA + (wm * 64 + m * 16 + fr) * LDSS + rs0);
#pragma unroll
    for (int n = 0; n < NF; ++n) bf0[n] = *(const bf16x8*)(cB + (wn * (16 * NF) + n * 16 + fr) * LDSS + rs0);
#pragma unroll
    for (int m = 0; m < 4; ++m) af1[m] = *(const bf16x8*)(cA + (wm * 64 + m * 16 + fr) * LDSS + rs1);
#pragma unroll
    for (int n = 0; n < NF; ++n) bf1[n] = *(const bf16x8*)(cB + (wn * (16 * NF) + n * 16 + fr) * LDSS + rs1);
    __builtin_amdgcn_sched_barrier(0);
#pragma unroll
    for (int m = 0; m < 4; ++m)
#pragma unroll
      for (int n = 0; n < NF; ++n) acc[m][n] = MFMA16(af0[m], bf0[n], acc[m][n]);
#pragma unroll
    for (int m = 0; m < 4; ++m)
#pragma unroll
      for (int n = 0; n < NF; ++n) acc[m][n] = MFMA16(af1[m], bf1[n], acc[m][n]);
  };
  gload(xa, xb, 0);
  __syncthreads();
  lwrite(xa, xb, 0, 0);
  gload(xa, xb, 64);
  __syncthreads();
  for (int k0 = 0; k0 < K; k0 += 128) {
    lwrite(xa, xb, k0 + 64, 1);
    if (k0 + 128 < K) gload(ya, yb, k0 + 128);
    __builtin_amdgcn_sched_barrier(0);
    compute(0);
    __syncthreads();
    if (k0 + 128 < K) lwrite(ya, yb, k0 + 128, 0);
    if (k0 + 192 < K) gload(xa, xb, k0 + 192);
    __builtin_amdgcn_sched_barrier(0);
    compute(1);
    __syncthreads();
  }
}
template <int NF, bool WIN = false>
DI void gemm_mainloop1(const u16* __restrict__ A, int lda, const u16* __restrict__ Bt, int ldb, int K, f32x4 (&acc)[4][NF], u16* sA, u16* sB, const float* __restrict__ pe = nullptr) {
  constexpr int GEMM_BUF = 384 * LDSS;
  const int tid = otid(), lane = tid & 63, wave = tid >> 6;
  const int wm = wave >> 1, wn = wave & 1, fr = lane & 15, fq = lane >> 4;
  u32x4 ra[4], rb[NF / 2];
  const int lrow = tid >> 3, lkc = (tid & 7) * 8;
  auto fix_pe = [&](int k0) {
    if (WIN) {
      const float* pp = pe + (k0 >> 7) * 128 + (k0 & 127) + lkc;
      const f32x4 q0 = *(const f32x4*)pp, q1 = *(const f32x4*)(pp + 4);
#pragma unroll
      for (int i = 0; i < 4; ++i) {
        u32x4 w;
        w[0] = (unsigned)f2bf(__uint_as_float(ra[i][0] << 16) + q0[0]) | ((unsigned)f2bf(__uint_as_float(ra[i][0] & 0xffff0000u) + q0[1]) << 16);
        w[1] = (unsigned)f2bf(__uint_as_float(ra[i][1] << 16) + q0[2]) | ((unsigned)f2bf(__uint_as_float(ra[i][1] & 0xffff0000u) + q0[3]) << 16);
        w[2] = (unsigned)f2bf(__uint_as_float(ra[i][2] << 16) + q1[0]) | ((unsigned)f2bf(__uint_as_float(ra[i][2] & 0xffff0000u) + q1[1]) << 16);
        w[3] = (unsigned)f2bf(__uint_as_float(ra[i][3] << 16) + q1[2]) | ((unsigned)f2bf(__uint_as_float(ra[i][3] & 0xffff0000u) + q1[3]) << 16);
        ra[i] = w;
      }
    }
  };
#pragma unroll
  for (int i = 0; i < 4; ++i) ra[i] = *(const u32x4*)(A + (size_t)(lrow + 64 * i) * lda + lkc);
#pragma unroll
  for (int i = 0; i < NF / 2; ++i) rb[i] = *(const u32x4*)(Bt + (size_t)(lrow + 64 * i) * ldb + lkc);
  __syncthreads();
  fix_pe(0);
#pragma unroll
  for (int i = 0; i < 4; ++i) *(u32x4*)(sA + (lrow + 64 * i) * LDSS + (((lkc >> 3) ^ ((lrow >> 1) & 7)) << 3)) = ra[i];
#pragma unroll
  for (int i = 0; i < NF / 2; ++i) *(u32x4*)(sB + (lrow + 64 * i) * LDSS + (((lkc >> 3) ^ ((lrow >> 1) & 7)) << 3)) = rb[i];
  __syncthreads();
  int buf = 0;
  for (int k0 = 0; k0 < K; k0 += 64) {
    const bool more = (k0 + 64 < K);
    if (more) {
#pragma unroll
      for (int i = 0; i < 4; ++i) ra[i] = *(const u32x4*)(A + (size_t)(lrow + 64 * i) * lda + (WIN ? (size_t)((k0 + 64) >> 7) * NP + ((k0 + 64) & 127) : (size_t)(k0 + 64)) + lkc);
#pragma unroll
      for (int i = 0; i < NF / 2; ++i) rb[i] = *(const u32x4*)(Bt + (size_t)(lrow + 64 * i) * ldb + k0 + 64 + lkc);
    }
    const u16* cA = sA + buf * GEMM_BUF;
    const u16* cB = sB + buf * GEMM_BUF;
    __builtin_amdgcn_sched_barrier(0);
#pragma unroll
    for (int ks = 0; ks < 2; ++ks) {
      bf16x8 af[4], bf[NF];
#pragma unroll
      for (int m = 0; m < 4; ++m) af[m] = *(const bf16x8*)(cA + (wm * 64 + m * 16 + fr) * LDSS + (((ks * 4 + fq) ^ ((fr >> 1) & 7)) << 3));
#pragma unroll
      for (int n = 0; n < NF; ++n) bf[n] = *(const bf16x8*)(cB + (wn * (16 * NF) + n * 16 + fr) * LDSS + (((ks * 4 + fq) ^ ((fr >> 1) & 7)) << 3));
#pragma unroll
      for (int m = 0; m < 4; ++m)
#pragma unroll
        for (int n = 0; n < NF; ++n) acc[m][n] = MFMA16(af[m], bf[n], acc[m][n]);
    }
    __builtin_amdgcn_sched_barrier(0);
    if (more) {
      fix_pe(k0 + 64);
      u16* nA = sA + (buf ^ 1) * GEMM_BUF;
      u16* nB = sB + (buf ^ 1) * GEMM_BUF;
#pragma unroll
      for (int i = 0; i < 4; ++i) *(u32x4*)(nA + (lrow + 64 * i) * LDSS + (((lkc >> 3) ^ ((lrow >> 1) & 7)) << 3)) = ra[i];
#pragma unroll
      for (int i = 0; i < NF / 2; ++i) *(u32x4*)(nB + (lrow + 64 * i) * LDSS + (((lkc >> 3) ^ ((lrow >> 1) & 7)) << 3)) = rb[i];
    }
    __syncthreads();
    buf ^= 1;
  }
}
template <int NF>
DI void gemm_mainloop_dma(const u16* __restrict__ A, int lda, const u16* __restrict__ Bt, int ldb, int K, f32x4 (&acc)[4][NF], u16* sbase) {
  constexpr int STG = 384 * LDSS;
  const int tid = otid(), lane = tid & 63, wave = tid >> 6;
  const int wm = wave >> 1, wn = wave & 1, fr = lane & 15, fq = lane >> 4;
  const int lrow = tid >> 3, lc = tid & 7;
  const int gsw = ((lc ^ ((lrow >> 1) & 7)) << 3);
  const u16* ga = A + (size_t)lrow * lda + gsw;
  const u16* gb = Bt + (size_t)lrow * ldb + gsw;
  auto issue = [&](int t, int buf) {
    u16* da = sbase + buf * STG + lrow * LDSS + lc * 8;
#pragma unroll
    for (int i = 0; i < 4; ++i)
      __builtin_amdgcn_global_load_lds((const unsigned*)(ga + (size_t)(64 * i) * lda + t * 64), (unsigned*)(da + (64 * i) * LDSS), 16, 0, 0);
#pragma unroll
    for (int i = 0; i < NF / 2; ++i)
      __builtin_amdgcn_global_load_lds((const unsigned*)(gb + (size_t)(64 * i) * ldb + t * 64), (unsigned*)(da + (256 + 64 * i) * LDSS), 16, 0, 0);
  };
  const int rs0 = ((fq ^ ((fr >> 1) & 7)) << 3), rs1 = (((4 + fq) ^ ((fr >> 1) & 7)) << 3);
  const int nk = K >> 6;
  __syncthreads();
  issue(0, 0);
  issue(1, 1);
  int buf = 0;
  for (int k = 0; k < nk; ++k) {
    if (k + 1 < nk) { if (NF == 4) asm volatile("s_waitcnt vmcnt(6)" ::: "memory"); else asm volatile("s_waitcnt vmcnt(5)" ::: "memory"); }
    else asm volatile("s_waitcnt vmcnt(0)" ::: "memory");
    asm volatile("s_waitcnt lgkmcnt(0)" ::: "memory");
    __builtin_amdgcn_s_barrier();
    if (k + 2 < nk) issue(k + 2, buf == 0 ? 2 : buf - 1);
    const u16* cA = sbase + buf * STG;
    const u16* cB = cA + 256 * LDSS;
    bf16x8 af0[4], bf0[NF], af1[4], bf1[NF];
#pragma unroll
    for (int m = 0; m < 4; ++m) af0[m] = *(const bf16x8*)(cA + (wm * 64 + m * 16 + fr) * LDSS + rs0);
#pragma unroll
    for (int n = 0; n < NF; ++n) bf0[n] = *(const bf16x8*)(cB + (wn * (16 * NF) + n * 16 + fr) * LDSS + rs0);
#pragma unroll
    for (int m = 0; m < 4; ++m) af1[m] = *(const bf16x8*)(cA + (wm * 64 + m * 16 + fr) * LDSS + rs1);
#pragma unroll
    for (int n = 0; n < NF; ++n) bf1[n] = *(const bf16x8*)(cB + (wn * (16 * NF) + n * 16 + fr) * LDSS + rs1);
#pragma unroll
    for (int m = 0; m < 4; ++m)
#pragma unroll
      for (int n = 0; n < NF; ++n) acc[m][n] = MFMA16(af0[m], bf0[n], acc[m][n]);
#pragma unroll
    for (int m = 0; m < 4; ++m)
#pragma unroll
      for (int n = 0; n < NF; ++n) acc[m][n] = MFMA16(af1[m], bf1[n], acc[m][n]);
    buf = (buf == 2) ? 0 : buf + 1;
  }
  __syncthreads();
}
DI void gemm_mainloop_big_dma(const u16* __restrict__ A, int lda, const u16* __restrict__ Bt, int ldb, int K, f32x4 (&acc)[8][4], u16* sbase) {
  constexpr int STG = 512 * LDSS;
  const int tid = otid(), lane = tid & 63, wave = tid >> 6;
  const int wm = wave >> 2, wn = wave & 3, fr = lane & 15, fq = lane >> 4;
  const int lrow = tid >> 3, lc = tid & 7;
  const int gsw = ((lc ^ ((lrow >> 1) & 7)) << 3);
  auto issue = [&](int t, int buf) {
    int lr = lrow; asm volatile("" : "+v"(lr));
    const u16* ga = A + (size_t)lr * lda + gsw;
    const u16* gb = Bt + (size_t)lr * ldb + gsw;
    u16* da = sbase + buf * STG + lr * LDSS + lc * 8;
#pragma unroll
    for (int i = 0; i < 4; ++i)
      __builtin_amdgcn_global_load_lds((const unsigned*)(ga + (size_t)(64 * i) * lda + t * 64), (unsigned*)(da + (64 * i) * LDSS), 16, 0, 0);
#pragma unroll
    for (int i = 0; i < 4; ++i)
      __builtin_amdgcn_global_load_lds((const unsigned*)(gb + (size_t)(64 * i) * ldb + t * 64), (unsigned*)(da + (256 + 64 * i) * LDSS), 16, 0, 0);
  };
  const int nk = K >> 6;
  __syncthreads();
  issue(0, 0);
  for (int k = 0; k < nk; ++k) {
    asm volatile("s_waitcnt vmcnt(0)" ::: "memory");
    asm volatile("s_waitcnt lgkmcnt(0)" ::: "memory");
    __builtin_amdgcn_s_barrier();
    if (k + 1 < nk) issue(k + 1, (k + 1) & 1);
    const u16* cA = sbase + (k & 1) * STG;
    const u16* cB = cA + 256 * LDSS;
#pragma unroll
    for (int ks = 0; ks < 2; ++ks) {
      const int rsw = (((ks * 4 + fq) ^ ((fr >> 1) & 7)) << 3);
      bf16x8 bf[4];
#pragma unroll
      for (int n = 0; n < 4; ++n) bf[n] = *(const bf16x8*)(cB + (wn * 64 + n * 16 + fr) * LDSS + rsw);
#pragma unroll
      for (int mh = 0; mh < 2; ++mh) {
        bf16x8 af[4];
#pragma unroll
        for (int m = 0; m < 4; ++m) af[m] = *(const bf16x8*)(cA + (wm * 128 + (mh * 4 + m) * 16 + fr) * LDSS + rsw);
#pragma unroll
        for (int m = 0; m < 4; ++m)
#pragma unroll
          for (int n = 0; n < 4; ++n) acc[mh * 4 + m][n] = MFMA16(af[m], bf[n], acc[mh * 4 + m][n]);
      }
    }
  }
  __syncthreads();
}
template <int NF>
DI void zero_acc(f32x4 (&acc)[4][NF]) {
#pragma unroll
  for (int m = 0; m < 4; ++m)
#pragma unroll
    for (int n = 0; n < NF; ++n) acc[m][n] = zero4();
}

struct ASt { f32x4 o[8]; float m; float l; };
DI void ast_init(ASt& s) {
#pragma unroll
  for (int i = 0; i < 8; ++i) s.o[i] = zero4();
  s.m = -1e30f; s.l = 0.f;
}
DI void attn_step(ASt& st, const bf16x8 (&qf)[4], const u16* __restrict__ kp, const u16* __restrict__ vp, unsigned vmask, float sc) {
  bf16x8 kf[8];
#pragma unroll
  for (int ks = 0; ks < 4; ++ks) { kf[2 * ks] = *(const bf16x8*)(kp + ks * 512); kf[2 * ks + 1] = *(const bf16x8*)(kp + 2048 + ks * 512); }
  f32x4 s0 = zero4(), s1 = zero4();
#pragma unroll
  for (int ks = 0; ks < 4; ++ks) {
    s0 = MFMA16(kf[2 * ks], qf[ks], s0);
    s1 = MFMA16(kf[2 * ks + 1], qf[ks], s1);
  }
  s16x4 vf[16];
#pragma unroll
  for (int dt = 0; dt < 8; ++dt) { vf[2 * dt] = *(const s16x4*)(vp + dt * 512); vf[2 * dt + 1] = *(const s16x4*)(vp + dt * 512 + 256); }
  float p[8];
#pragma unroll
  for (int r = 0; r < 4; ++r) { p[r] = s0[r] * sc; p[4 + r] = s1[r] * sc; }
  float tmax = -1e30f;
#pragma unroll
  for (int i = 0; i < 8; ++i) tmax = ((vmask >> i) & 1u) ? fmaxf(tmax, p[i]) : tmax;
  tmax = fmaxf(tmax, __shfl_xor(tmax, 16));
  tmax = fmaxf(tmax, __shfl_xor(tmax, 32));
  const float mn = fmaxf(st.m, tmax);
  const float alpha = exp2f(st.m - mn);
  st.m = mn;
  float ps = 0.f;
#pragma unroll
  for (int i = 0; i < 8; ++i) { p[i] = ((vmask >> i) & 1u) ? exp2f(p[i] - mn) : 0.f; ps += p[i]; }
  st.l = st.l * alpha + ps;
  bf16x8 pb;
#pragma unroll
  for (int i = 0; i < 8; ++i) pb[i] = (short)f2bf(p[i]);
#pragma unroll
  for (int dt = 0; dt < 8; ++dt) st.o[dt] = st.o[dt] * alpha;
#pragma unroll
  for (int dt = 0; dt < 8; ++dt) st.o[dt] = MFMA16(cat8(vf[2 * dt], vf[2 * dt + 1]), pb, st.o[dt]);
}
template <bool FULL>
DI void attn_block(ASt& st, const bf16x8 (&qf)[4], const u16* __restrict__ cur, int lane, unsigned vmask, bool col, float sc) {
  const u16* kp = cur + lane * 8;
  const u16* vp = cur + 8192 + lane * 4;
  f32x4 s[4];
#pragma unroll
  for (int h = 0; h < 2; ++h) {
    bf16x8 kf[8];
#pragma unroll
    for (int ks = 0; ks < 4; ++ks) { kf[2 * ks] = *(const bf16x8*)(kp + (2 * h) * 2048 + ks * 512); kf[2 * ks + 1] = *(const bf16x8*)(kp + (2 * h + 1) * 2048 + ks * 512); }
    f32x4 a = zero4(), b = zero4();
#pragma unroll
    for (int ks = 0; ks < 4; ++ks) { a = MFMA16(kf[2 * ks], qf[ks], a); b = MFMA16(kf[2 * ks + 1], qf[ks], b); }
    s[2 * h] = a; s[2 * h + 1] = b;
  }
  s16x4 vf[16];
#pragma unroll
  for (int dt = 0; dt < 8; ++dt) { vf[2 * dt] = *(const s16x4*)(vp + dt * 512); vf[2 * dt + 1] = *(const s16x4*)(vp + dt * 512 + 256); }
  float p[16];
  float tmax = -1e30f;
  if (FULL) {
#pragma unroll
    for (int i = 0; i < 16; ++i) { p[i] = s[i >> 2][i & 3] * sc; tmax = fmaxf(tmax, p[i]); }
    tmax = col ? tmax : -1e30f;
  } else {
#pragma unroll
    for (int i = 0; i < 16; ++i) { p[i] = s[i >> 2][i & 3] * sc; tmax = ((vmask >> i) & 1u) ? fmaxf(tmax, p[i]) : tmax; }
  }
  if (__any(tmax > st.m + 8.f)) {
    float tm = fmaxf(tmax, __shfl_xor(tmax, 16));
    tm = fmaxf(tm, __shfl_xor(tm, 32));
    const float mn = fmaxf(st.m, tm);
    const float alpha = fexp2(st.m - mn);
    st.m = mn;
    st.l *= alpha;
#pragma unroll
    for (int dt = 0; dt < 8; ++dt) st.o[dt] = st.o[dt] * alpha;
  }
  float ps = 0.f;
  if (FULL) {
#pragma unroll
    for (int i = 0; i < 16; ++i) { p[i] = col ? fexp2(p[i] - st.m) : 0.f; ps += p[i]; }
  } else {
#pragma unroll
    for (int i = 0; i < 16; ++i) { p[i] = ((vmask >> i) & 1u) ? fexp2(p[i] - st.m) : 0.f; ps += p[i]; }
  }
  st.l += ps;
  const float pa[8] = {p[0], p[1], p[2], p[3], p[4], p[5], p[6], p[7]};
  const float pc[8] = {p[8], p[9], p[10], p[11], p[12], p[13], p[14], p[15]};
  const bf16x8 pb0 = pack8(pa), pb1 = pack8(pc);
#pragma unroll
  for (int dt = 0; dt < 8; ++dt) st.o[dt] = MFMA16(cat8(vf[2 * dt], vf[2 * dt + 1]), pb0, st.o[dt]);
#pragma unroll
  for (int dt = 0; dt < 8; ++dt) { vf[2 * dt] = *(const s16x4*)(vp + 4096 + dt * 512); vf[2 * dt + 1] = *(const s16x4*)(vp + 4096 + dt * 512 + 256); }
#pragma unroll
  for (int dt = 0; dt < 8; ++dt) st.o[dt] = MFMA16(cat8(vf[2 * dt], vf[2 * dt + 1]), pb1, st.o[dt]);
}
DI float ast_inv(const ASt& st) {
  float l = st.l;
  l += __shfl_xor(l, 16);
  l += __shfl_xor(l, 32);
  return l > 0.f ? 1.f / l : 0.f;
}

constexpr float SC_LOG2E = 0.08838834764831845f * 1.4426950408889634f;

#define XB_TMO      128
#define XB_XCNT(j)  (256  + 64 * (j))
#define XB_XSUB(j)  (1280 + 64 * (j))
#define XB_XGEN(j)  (2304 + 64 * (j))
#define XB_TOP      3328
#define XB_TOPGEN   3392
#define XCD_BAR_WORDS 3456
#define XB_SPIN_CAP (1u << 22)
#define LAS __attribute__((address_space(3)))
DI unsigned xb_ld(unsigned* p)              { return __hip_atomic_load(p, __ATOMIC_RELAXED, __HIP_MEMORY_SCOPE_AGENT); }
DI unsigned xb_add(unsigned* p, unsigned v) { return __hip_atomic_fetch_add(p, v, __ATOMIC_RELAXED, __HIP_MEMORY_SCOPE_AGENT); }
DI unsigned xb_xcc_id() { return (unsigned)__builtin_amdgcn_s_getreg((3 << 11) | 20) & 0xFu; }
#define XB_SPIN(cond, bar) do { unsigned _sp = 0; while (cond) { __builtin_amdgcn_s_sleep(1); \
    if ((++_sp & 255u) == 0u) { if (xb_ld(&(bar)[XB_TMO])) break; if (_sp > XB_SPIN_CAP) { atomicAdd(&(bar)[XB_TMO], 1u); break; } } } } while (0)
struct XcdBarrier { unsigned* bar; unsigned x; volatile LAS unsigned* st; };
DI XcdBarrier xcd_barrier_post(unsigned* bar, volatile LAS unsigned* st) {
  XcdBarrier b; b.bar = bar; b.x = xb_xcc_id(); b.st = st;
  if (threadIdx.x == 0) (void)xb_add(&bar[XB_XCNT(b.x)], 1u);
  return b;
}
DI void xcd_barrier_complete(unsigned* bar, unsigned x, unsigned& nloc, unsigned& nx) {
  const unsigned G = gridDim.x * gridDim.y * gridDim.z;
  unsigned sum, cnt, mine, sp = 0u;
  for (;;) {
    sum = 0u; cnt = 0u; mine = 0u;
#pragma unroll
    for (unsigned j = 0; j < 16; ++j) { const unsigned c = xb_ld(&bar[XB_XCNT(j)]); sum += c; cnt += (c > 0u) ? 1u : 0u; mine = (j == x) ? c : mine; }
    if (sum == G) break;
    __builtin_amdgcn_s_sleep(1);
    if ((++sp & 255u) == 0u) { if (xb_ld(&bar[XB_TMO])) break; if (sp > XB_SPIN_CAP) { atomicAdd(&bar[XB_TMO], 1u); break; } }
  }
  nloc = mine > 0u ? mine : 1u; nx = cnt > 0u ? cnt : 1u;
}
DI void xcd_barrier(const XcdBarrier& b) {
  asm volatile("s_waitcnt vmcnt(0)" ::: "memory");
  __syncthreads();
  if (threadIdx.x == 0) {
    unsigned* bar = b.bar;
    __builtin_amdgcn_s_waitcnt(0);
    unsigned nloc = b.st[0], nx = b.st[1];
    if (nloc == 0u) { xcd_barrier_complete(bar, b.x, nloc, nx); b.st[0] = nloc; b.st[1] = nx; }
    const unsigned old = xb_add(&bar[XB_XSUB(b.x)], 1u);
    const unsigned gen = old / nloc;
    if (old + 1u == (gen + 1u) * nloc) {
      __builtin_amdgcn_fence(__ATOMIC_RELEASE, "agent");
      asm volatile("s_waitcnt vmcnt(0)" ::: "memory");
      const unsigned og = xb_add(&bar[XB_TOP], 1u);
      const unsigned tg = og / nx;
      if (og + 1u == (tg + 1u) * nx) xb_add(&bar[XB_TOPGEN], 1u);
      else XB_SPIN(xb_ld(&bar[XB_TOPGEN]) == tg, bar);
      __builtin_amdgcn_fence(__ATOMIC_ACQUIRE, "agent");
      xb_add(&bar[XB_XGEN(b.x)], 1u);
      asm volatile("s_waitcnt vmcnt(0)" ::: "memory");
    } else {
      XB_SPIN(xb_ld(&bar[XB_XGEN(b.x)]) == gen, bar);
      __builtin_amdgcn_fence(__ATOMIC_ACQUIRE, "agent");
      asm volatile("s_waitcnt vmcnt(0)" ::: "memory");
    }
  }
  __syncthreads();
}

struct Ctx {
  Params p; int b; int l;
  DI char* lw() const { return p.ws + LW_SIZE * (size_t)l; }
};

DI float rope_inv_freq(int f) {
  switch (f) {
    case 0: return 1.000000000e+00f;
    case 1: return 4.403665960e-01f;
    case 2: return 1.939227432e-01f;
    case 3: return 8.539710194e-02f;
    case 4: return 3.760603070e-02f;
    case 5: return 1.656044088e-02f;
    case 6: return 7.292664610e-03f;
    case 7: return 3.211446106e-03f;
    case 8: return 1.414213562e-03f;
    case 9: return 6.227724371e-04f;
    case 10: return 2.742481884e-04f;
    case 11: return 1.207697351e-04f;
    case 12: return 5.318295734e-05f;
    case 13: return 2.341999971e-05f;
    case 14: return 1.031338525e-05f;
    case 15: return 4.541670478e-06f;
    default: return 0.f;
  }
}
DI void phase_weights(const Params& p, u16* lds) {
  constexpr int PER_LAYER = 2336 + 128 + 256 + 128 + 256 + 256 + 128 + 128 + 4 + 4;
  for (int it = blockIdx.x; it < PER_LAYER * DEPTH; it += gridDim.x) {
    const int l = it / PER_LAYER; int r = it % PER_LAYER;
    char* lw = p.ws + LW_SIZE * (size_t)l;
    const float* src; int ldsrc, K, ntn; u16* dst; bool wm = false;
    if (r < 2336) { src = p.w_in + (size_t)l * 1024 * DIN; ldsrc = DIN; K = 1024; ntn = 146; dst = (u16*)(lw + LW_WIN); wm = true; }
    else if ((r -= 2336) < 128) { src = p.w_a + (size_t)l * 512 * 1024; ldsrc = 1024; K = 512; ntn = 16; dst = (u16*)(lw + LW_WA); }
    else if ((r -= 128) < 256) { src = p.w_b + (size_t)l * 1024 * 1024; ldsrc = 1024; K = 1024; ntn = 16; dst = (u16*)(lw + LW_WB); }
    else if ((r -= 256) < 128) { src = p.w_c + (size_t)l * 512 * 1024; ldsrc = 1024; K = 512; ntn = 16; dst = (u16*)(lw + LW_WC); }
    else if ((r -= 128) < 256) { src = p.w_out + (size_t)l * 1024 * 1024; ldsrc = 1024; K = 1024; ntn = 16; dst = (u16*)(lw + LW_WO); }
    else if ((r -= 256) < 256) { src = p.w_memkv + (size_t)l * 1024 * 1024; ldsrc = 1024; K = 1024; ntn = 16; dst = (u16*)(lw + LW_WMKV); }
    else if ((r -= 256) < 128) { src = p.w1_k + (size_t)l * 4096 * 128; ldsrc = 128; K = 4096; ntn = 2; dst = (u16*)(lw + LW_W1K); }
    else if ((r -= 128) < 128) { src = p.w1_v + (size_t)l * 4096 * 128; ldsrc = 128; K = 4096; ntn = 2; dst = (u16*)(lw + LW_W1V); }
    else if ((r -= 128) < 4) { src = p.w2_k + (size_t)l * 128 * 128; ldsrc = 128; K = 128; ntn = 2; dst = (u16*)(lw + LW_W2K); }
    else { r -= 4; src = p.w2_v + (size_t)l * 128 * 128; ldsrc = 128; K = 128; ntn = 2; dst = (u16*)(lw + LW_W2V); }
    const int nt = r % ntn, kt = r / ntn;
    transpose_tile(src, ldsrc, K, dst, nt * 64, kt * 64, wm, lds);
  }
  const int gtid = blockIdx.x * 512 + otid(), gstride = gridDim.x * 512;
  for (int i = gtid; i < DEPTH * 65536; i += gstride) {
    const int l = i >> 16, e = i & 65535, t = (e >> 7) & 127, s = e & 127;
    const float v = (s <= t) ? p.w_sp[i] : 0.f;
    ((u16*)(p.ws + LW_SIZE * (size_t)l + LW_WSP))[e] = f2bf(v);
  }
  float2* rt = (float2*)(p.ws + OFF_ROPE);
  for (int i = gtid; i < NBATCH * S * 16; i += gstride) {
    const int f = i & 15, bs = i >> 4;
    const float inv = rope_inv_freq(f);
    const float ang = (float)p.pos[bs] * inv;
    float sn, cs; sincosf(ang, &sn, &cs);
    rt[i] = make_float2(cs, sn);
  }
  const int gw = (blockIdx.x * 512 + otid()) >> 6, nw = gridDim.x * 8;
  for (int row = gw; row < NBATCH * 256; row += nw)
    rmsnorm_row_bf16(p.mem + (size_t)row * 1024, p.mem_gain, (u16*)(p.ws + OFF_MEMN) + (size_t)row * 1024);
}

DI void phase_memkv(const Params& p, u16* lds) {
  const int tid = otid(), lane = tid & 63, wave = tid >> 6, wm = wave >> 1, wn = wave & 1, fr = lane & 15, fq = lane >> 4;
  for (int it = blockIdx.x; it < DEPTH * 32; it += gridDim.x) {
    const int l = it >> 5, mt = (it >> 3) & 3, nt = it & 7;
    f32x4 acc[4][4]; zero_acc<4>(acc);
    gemm_mainloop1<4>((const u16*)(p.ws + OFF_MEMN) + (size_t)mt * 256 * 1024, 1024,
                  (const u16*)(p.ws + LW_SIZE * (size_t)l + LW_WMKV) + (size_t)nt * 128 * 1024, 1024, 1024, acc, lds, lds + 256 * LDSS);
    const int b = mt, kv = nt >> 2, h = nt & 3;
    u16* mk = (u16*)(p.ws + OFF_MK + (size_t)l * MB) + (size_t)(b * 4 + h) * 256 * 128;
    u16* mvt = (u16*)(p.ws + OFF_MVT + (size_t)l * MB) + (size_t)(b * 4 + h) * 128 * 256;
#pragma unroll
    for (int m = 0; m < 4; ++m)
#pragma unroll
      for (int n = 0; n < 4; ++n) {
        const int mrow = wm * 64 + m * 16 + fq * 4;
        const int d = wn * 64 + n * 16 + fr;
        if (kv == 0) {
#pragma unroll
          for (int r = 0; r < 4; ++r) mk[offK(mrow + r, d)] = f2bf(acc[m][n][r]);
        } else {
          *(s16x4*)(mvt + offV(mrow, d)) = pack4(acc[m][n]);
        }
      }
  }
}

DI void phase_norm(const Ctx& c) {
  const float* xin = (c.l == 0 ? c.p.x : c.p.out) + (size_t)c.b * S * DM;
  const float* gain = c.p.norm_gain + c.l * DM;
  u16* h = (u16*)(c.p.ws + OFF_H);
  const int gw = (blockIdx.x * 512 + otid()) >> 6, nw = gridDim.x * 8;
  for (int row = gw; row < S; row += nw) rmsnorm_row_bf16(xin + (size_t)row * DM, gain, h + (size_t)row * DM);
}

DI void phase_proj(const Ctx& c, u16* lds) {
  const int tid = otid(), lane = tid & 63, wave = tid >> 6, wm = wave >> 1, wn = wave & 1, fr = lane & 15, fq = lane >> 4;
  const u16* h = (const u16*)(c.p.ws + OFF_H);
  const u16* wint = (const u16*)(c.lw() + LW_WIN);
  u16* proj = (u16*)(c.p.ws + OFF_PROJ);
  const float2* rt = (const float2*)(c.p.ws + OFF_ROPE) + (size_t)c.b * S * 16;
  {
    const int wmB = wave >> 2, wn4 = wave & 3;
  for (int it = blockIdx.x; it < 32 * 32; it += gridDim.x) {
    const int nt2 = it >> 5, mt = it & 31;
    f32x4 acc[8][4];
#pragma unroll
    for (int m = 0; m < 8; ++m)
#pragma unroll
      for (int n = 0; n < 4; ++n) acc[m][n] = zero4();
    gemm_mainloop_big_dma(h + (size_t)mt * 256 * 1024, 1024, wint + (size_t)nt2 * 256 * 1024, 1024, 1024, acc, lds);
    int fr2 = fr, fq2 = fq; asm volatile("" : "+v"(fr2), "+v"(fq2));
    const int wv = otid() >> 6;
    const int nt = nt2 * 2 + ((wv & 3) >> 1);
    const int wn = wv & 1;
    const int row_base = mt * 256 + (wv >> 2) * 128;
    if (nt < 73) {
      const bool rope = (nt >= 12 && nt < 20) || nt == 28 || nt == 29 || nt == 32 || nt == 33 || nt == 36 || nt == 37;
      if (rope && wn == 0) {
#pragma unroll
        for (int m = 0; m < 8; ++m)
#pragma unroll
          for (int r = 0; r < 4; ++r) {
            const int tok = row_base + m * 16 + fq2 * 4 + r;
            const float2 cs = rt[(size_t)tok * 16 + fr2];
            const float t1 = acc[m][0][r], t2 = acc[m][1][r];
            acc[m][0][r] = t1 * cs.x - t2 * cs.y;
            acc[m][1][r] = t2 * cs.x + t1 * cs.y;
          }
      }
      if (nt == 34 || nt == 35 || nt == 38 || nt == 39) {
        u16* dst = (u16*)(c.p.ws + (nt < 36 ? OFF_VTS : OFF_VTW)) + (size_t)((nt & 1) * 128) * S;
#pragma unroll
        for (int m = 0; m < 8; ++m)
#pragma unroll
          for (int n = 0; n < 4; ++n) {
            const int d = wn * 64 + n * 16 + fr2, tok = row_base + m * 16 + fq2 * 4;
            *(s16x4*)(dst + offV(tok, d)) = pack4(acc[m][n]);
          }
      } else if (nt == 32 || nt == 33 || nt == 36 || nt == 37) {
        u16* dst = (u16*)(c.p.ws + (nt < 36 ? OFF_KS : OFF_KW)) + (size_t)((nt & 1) * 128) * S;
#pragma unroll
        for (int m = 0; m < 8; ++m)
#pragma unroll
          for (int n = 0; n < 4; ++n) {
            const s16x4 v = pack4(acc[m][n]);
#pragma unroll
            for (int r = 0; r < 4; ++r) dst[offK(row_base + m * 16 + fq2 * 4 + r, wn * 64 + n * 16 + fr2)] = (u16)v[r];
          }
      } else {
#pragma unroll
        for (int m = 0; m < 8; ++m)
#pragma unroll
          for (int n = 0; n < 4; ++n) {
            const s16x4 v = pack4(acc[m][n]);
#pragma unroll
            for (int r = 0; r < 4; ++r) proj[(size_t)(row_base + m * 16 + fq2 * 4 + r) * NP + nt * 128 + wn * 64 + n * 16 + fr2] = (u16)v[r];
          }
      }
    }
  }
  }
  {
  const int tid = otid(), lane = tid & 63, wave = tid >> 6, wm = wave >> 1, wn = wave & 1, fr = lane & 15, fq = lane >> 4;
  for (int it = blockIdx.x; it < 32 * 8; it += gridDim.x) {
    const int nt = 64 + (it >> 5), mt = it & 31;
    f32x4 acc[4][4]; zero_acc<4>(acc);
    gemm_mainloop_dma<4>(h + (size_t)mt * 256 * 1024, 1024, wint + (size_t)nt * 128 * 1024, 1024, 1024, acc, lds);
    const int row_base = mt * 256 + wm * 64;
    const bool rope = (nt >= 12 && nt < 20) || nt == 28 || nt == 29 || nt == 32 || nt == 33 || nt == 36 || nt == 37;
    if (rope && wn == 0) {
#pragma unroll
      for (int m = 0; m < 4; ++m)
#pragma unroll
        for (int r = 0; r < 4; ++r) {
          const int tok = row_base + m * 16 + fq * 4 + r;
          const float2 cs = rt[(size_t)tok * 16 + fr];
          const float t1 = acc[m][0][r], t2 = acc[m][1][r];
          acc[m][0][r] = t1 * cs.x - t2 * cs.y;
          acc[m][1][r] = t2 * cs.x + t1 * cs.y;
        }
    }
    if (nt == 34 || nt == 35 || nt == 38 || nt == 39) {
      u16* dst = (u16*)(c.p.ws + (nt < 36 ? OFF_VTS : OFF_VTW)) + (size_t)((nt & 1) * 128) * S;
#pragma unroll
      for (int m = 0; m < 4; ++m)
#pragma unroll
        for (int n = 0; n < 4; ++n) {
          const int d = wn * 64 + n * 16 + fr, tok = row_base + m * 16 + fq * 4;
          *(s16x4*)(dst + offV(tok, d)) = pack4(acc[m][n]);
        }
    } else {
      constexpr int PS = 136;
#pragma unroll
      for (int m = 0; m < 4; ++m)
#pragma unroll
        for (int n = 0; n < 4; ++n) {
          const s16x4 v = pack4(acc[m][n]);
#pragma unroll
          for (int r = 0; r < 4; ++r) lds[(wm * 64 + m * 16 + fq * 4 + r) * PS + wn * 64 + n * 16 + fr] = (u16)v[r];
        }
      __syncthreads();
      const bool kblk = (nt == 32 || nt == 33 || nt == 36 || nt == 37);
      u16* kdst = (u16*)(c.p.ws + (nt < 36 ? OFF_KS : OFF_KW)) + (size_t)((nt & 1) * 128) * S;
#pragma unroll
      for (int i = 0; i < 8; ++i) {
        const int cidx = tid + 512 * i, row = cidx >> 4, ch = cidx & 15;
        const u32x4 v = *(const u32x4*)(lds + row * PS + ch * 8);
        if (kblk) *(u32x4*)(kdst + offK(mt * 256 + row, ch * 8)) = v;
        else *(u32x4*)(proj + (size_t)(mt * 256 + row) * NP + nt * 128 + ch * 8) = v;
      }
    }
  }
  }
}

DI void brancha_item(const Ctx& c, int ch, int g, u16* vnT) {
  const int tid = otid(), lane = tid & 63, wave = tid >> 6, wm = wave >> 1, wn = wave & 1, fr = lane & 15, fq = lane >> 4;
  const u16* proj = (const u16*)(c.p.ws + OFF_PROJ);
  const int tk0 = ch * 128;
  constexpr int VS = 136;
  __syncthreads();
  {
    const float* lg = c.p.ln_g + c.l * 512 + lane * 8;
    const float* lb = c.p.ln_b + c.l * 512 + lane * 8;
    float gg[8], bb[8];
#pragma unroll
    for (int j = 0; j < 8; ++j) { gg[j] = lg[j]; bb[j] = lb[j]; }
#pragma unroll 8
    for (int rr = 0; rr < 16; ++rr) {
      const int row = wave * 16 + rr;
      const bf16x8 raw = *(const bf16x8*)(proj + (size_t)(tk0 + row) * NP + C_AV + lane * 8);
      float xv[8]; float sm = 0.f;
#pragma unroll
      for (int j = 0; j < 8; ++j) { xv[j] = bf2f_s(raw[j]); sm += xv[j]; }
      const float mean = wave_sum(sm) * (1.f / 512.f);
      float sq = 0.f;
#pragma unroll
      for (int j = 0; j < 8; ++j) { xv[j] -= mean; sq += xv[j] * xv[j]; }
      const float rstd = rsqrtf(wave_sum(sq) * (1.f / 512.f) + 1e-6f);
      if ((lane >> 4) == g) {
#pragma unroll
        for (int j = 0; j < 8; ++j) vnT[((lane & 15) * 8 + j) * VS + row] = f2bf(xv[j] * rstd * gg[j] + bb[j]);
      }
    }
  }
  __syncthreads();
  const u16* wsp = (const u16*)(c.lw() + LW_WSP) + (size_t)g * 16384;
  f32x4 acc[2][4];
#pragma unroll
  for (int m = 0; m < 2; ++m)
#pragma unroll
    for (int n = 0; n < 4; ++n) acc[m][n] = zero4();
#pragma unroll
  for (int ks = 0; ks < 4; ++ks) {
    bf16x8 af[2], bf[4];
#pragma unroll
    for (int m = 0; m < 2; ++m) af[m] = *(const bf16x8*)(wsp + (wm * 32 + m * 16 + fr) * 128 + ks * 32 + fq * 8);
#pragma unroll
    for (int n = 0; n < 4; ++n) bf[n] = *(const bf16x8*)(vnT + (wn * 64 + n * 16 + fr) * VS + ks * 32 + fq * 8);
#pragma unroll
    for (int m = 0; m < 2; ++m)
#pragma unroll
      for (int n = 0; n < 4; ++n) acc[m][n] = MFMA16(af[m], bf[n], acc[m][n]);
  }
  const float* bsp = c.p.b_sp + c.l * 512 + g * 128;
  u16* oa = (u16*)(c.p.ws + OFF_OA);
#pragma unroll 1
  for (int pass = 0; pass < 2; ++pass) {
    __syncthreads();
#pragma unroll
    for (int i = 0; i < 4; ++i) {
      const int cidx = tid + 512 * i, row = cidx >> 4, ch = cidx & 15;
      *(u32x4*)(vnT + row * VS + ch * 8) = *(const u32x4*)(proj + (size_t)(tk0 + row) * NP + (pass == 0 ? C_AU : C_AZ) + g * 128 + ch * 8);
    }
    __syncthreads();
#pragma unroll
    for (int m = 0; m < 2; ++m)
#pragma unroll
      for (int r = 0; r < 4; ++r) {
        const int t = wm * 32 + m * 16 + fq * 4 + r;
        const float bs = (pass == 0) ? bsp[t] : 0.f;
#pragma unroll
        for (int n = 0; n < 4; ++n) {
          const float v = bf2f(vnT[t * VS + wn * 64 + n * 16 + fr]);
          acc[m][n][r] = (pass == 0) ? (acc[m][n][r] + bs) * v : acc[m][n][r] * siluf_(v);
        }
      }
  }
  __syncthreads();
#pragma unroll
  for (int m = 0; m < 2; ++m)
#pragma unroll
    for (int n = 0; n < 4; ++n) {
      const s16x4 v = pack4(acc[m][n]);
#pragma unroll
      for (int r = 0; r < 4; ++r) vnT[(wm * 32 + m * 16 + fq * 4 + r) * VS + wn * 64 + n * 16 + fr] = (u16)v[r];
    }
  __syncthreads();
#pragma unroll
  for (int i = 0; i < 4; ++i) {
    const int cidx = tid + 512 * i, row = cidx >> 4, ch = cidx & 15;
    *(u32x4*)(oa + (size_t)(tk0 + row) * 512 + g * 128 + ch * 8) = *(const u32x4*)(vnT + row * VS + ch * 8);
  }
}

DI void memattn_item(const Ctx& c, int item) {
  const int lane = otid() & 63, fr = lane & 15, fq = lane >> 4;
  const int h = item & 3, tt = item >> 2;
  const int tc = tt * 16 + fr;
  const u16* proj = (const u16*)(c.p.ws + OFF_PROJ);
  bf16x8 qf[4];
#pragma unroll
  for (int ks = 0; ks < 4; ++ks) {
    const bf16x8 raw = *(const bf16x8*)(proj + (size_t)tc * NP + C_CQ + h * 128 + ks * 32 + fq * 8);
    float qs[8];
#pragma unroll
    for (int j = 0; j < 8; ++j) qs[j] = bf2f_s(raw[j]) * SC_LOG2E;
    qf[ks] = pack8(qs);
  }
  const u16* mk = (const u16*)(c.p.ws + OFF_MK + (size_t)c.l * MB) + (size_t)(c.b * 4 + h) * 256 * 128;
  const u16* mvt = (const u16*)(c.p.ws + OFF_MVT + (size_t)c.l * MB) + (size_t)(c.b * 4 + h) * 128 * 256;
  ASt st; ast_init(st);
  for (int key0 = 0; key0 < 256; key0 += 32)
    attn_step(st, qf, mk + (key0 >> 4) * 2048 + lane * 8, mvt + (key0 >> 5) * 4096 + lane * 4, 0xFFu, 1.f);
  const float inv = ast_inv(st);
  u16* oc = (u16*)(c.p.ws + OFF_OC);
#pragma unroll
  for (int dt = 0; dt < 8; ++dt) {
    const int d = h * 128 + dt * 16 + fq * 4;
    const s16x4 z = *(const s16x4*)(proj + (size_t)tc * NP + C_CZ + d);
    f32x4 o;
#pragma unroll
    for (int r = 0; r < 4; ++r) o[r] = st.o[dt][r] * inv * siluf_(bf2f_s(z[r]));
    *(s16x4*)(oc + (size_t)tc * 512 + d) = pack4(o);
  }
}

DI void compress_split_item(const Ctx& c, int idx, u16* lds) {
  const int tid = otid(), lane = tid & 63, wave = tid >> 6, wm = wave >> 1, wn = wave & 1, fr = lane & 15, fq = lane >> 4;
  const int kv = idx >> 5, g = (idx >> 4) & 1, mt = (idx >> 3) & 1, ks = idx & 7;
  const u16* A = (const u16*)(c.p.ws + OFF_PROJ) + C_KV + kv * 256 + g * 128 + (size_t)(mt * 256) * 16 * NP + (size_t)(ks * 4) * NP;
  const u16* w1t = (const u16*)(c.lw() + (kv ? LW_W1V : LW_W1K)) + ks * 512;
  const float* pe = (kv ? c.p.pe_v : c.p.pe_k) + (size_t)c.l * 32 * 128 + ks * 512;
  f32x4 acc[4][4]; zero_acc<4>(acc);
  gemm_mainloop<4, true>(A, 16 * NP, w1t, 4096, 512, acc, lds, lds + 256 * LDSS, pe);
  float* part = (float*)(c.p.ws + OFF_TOT) + (size_t)(((ks * 2 + kv) * 2 + g) * 512 + mt * 256) * 128;
#pragma unroll
  for (int m = 0; m < 4; ++m)
#pragma unroll
    for (int n = 0; n < 4; ++n)
#pragma unroll
      for (int r = 0; r < 4; ++r) part[(size_t)(wm * 64 + m * 16 + fq * 4 + r) * 128 + wn * 64 + n * 16 + fr] = acc[m][n][r];
}
DI void compress_final_item(const Ctx& c, int idx, u16* lds) {
  const int tid = otid(), lane = tid & 63, wave = tid >> 6, wm = wave >> 1, wn = wave & 1, fr = lane & 15, fq = lane >> 4;
  const int kv = idx >> 4, g = (idx >> 3) & 1, sl = idx & 7;
  const u16* w2t = (const u16*)(c.lw() + (kv ? LW_W2V : LW_W2K));
  constexpr int HS = 136;
  __syncthreads();
#pragma unroll
  for (int i = 0; i < 4; ++i) {
    const int cidx = tid + 512 * i, row = cidx >> 5, c4 = cidx & 31;
    f32x4 sum = zero4();
#pragma unroll
    for (int ks = 0; ks < 8; ++ks)
      sum += *(const f32x4*)((const float*)(c.p.ws + OFF_TOT) + (size_t)(((ks * 2 + kv) * 2 + g) * 512 + sl * 64 + row) * 128 + c4 * 4);
    f32x4 hv;
#pragma unroll
    for (int r = 0; r < 4; ++r) hv[r] = siluf_(sum[r]);
    *(s16x4*)(lds + row * HS + c4 * 4) = pack4(hv);
  }
  __syncthreads();
  f32x4 acc[4];
#pragma unroll
  for (int n = 0; n < 4; ++n) acc[n] = zero4();
#pragma unroll
  for (int ks = 0; ks < 4; ++ks) {
    const bf16x8 af = *(const bf16x8*)(lds + (wm * 16 + fr) * HS + ks * 32 + fq * 8);
#pragma unroll
    for (int n = 0; n < 4; ++n) {
      const bf16x8 bf = *(const bf16x8*)(w2t + (wn * 64 + n * 16 + fr) * 128 + ks * 32 + fq * 8);
      acc[n] = MFMA16(af, bf, acc[n]);
    }
  }
  u16* kc = (u16*)(c.p.ws + OFF_KCMP) + (size_t)g * 512 * 128;
  u16* vct = (u16*)(c.p.ws + OFF_VCMPT) + (size_t)g * 128 * 512;
#pragma unroll
  for (int n = 0; n < 4; ++n) {
    const int nrow = sl * 64 + wm * 16 + fq * 4, d = wn * 64 + n * 16 + fr;
    if (kv == 0) {
#pragma unroll
      for (int r = 0; r < 4; ++r) kc[offK(nrow + r, d)] = f2bf(acc[n][r]);
    } else {
      *(s16x4*)(vct + offV(nrow, d)) = pack4(acc[n]);
    }
  }
}

DI void gates_item(const Ctx& c, int item) {
  const int lane = otid() & 63, fr = lane & 15, fq = lane >> 4;
  const u16* h = (const u16*)(c.p.ws + OFF_H) + (size_t)(item * 16 + fr) * 1024 + fq * 8;
  const u16* w = (const u16*)(c.lw() + LW_WIN) + (size_t)(C_BG + fr) * 1024 + fq * 8;
  f32x4 a0 = zero4(), a1 = zero4();
#pragma unroll 4
  for (int ks = 0; ks < 32; ++ks) {
    const bf16x8 af = *(const bf16x8*)(h + ks * 32);
    const bf16x8 b0 = *(const bf16x8*)(w + ks * 32);
    const bf16x8 b1 = *(const bf16x8*)(w + 16 * 1024 + ks * 32);
    a0 = MFMA16(af, b0, a0);
    a1 = MFMA16(af, b1, a1);
  }
  u16* proj = (u16*)(c.p.ws + OFF_PROJ);
#pragma unroll
  for (int r = 0; r < 4; ++r) {
    proj[(size_t)(item * 16 + fq * 4 + r) * NP + C_BG + fr] = f2bf(a0[r]);
    proj[(size_t)(item * 16 + fq * 4 + r) * NP + C_BG + 16 + fr] = f2bf(a1[r]);
  }
}

DI void phase_p2(const Ctx& c, u16* lds) {
  const int wave = otid() >> 6;
  for (int it = blockIdx.x; it < 64 + 256 + 64; it += gridDim.x) {
    if (it < 64) compress_split_item(c, it, lds);
    else if (it < 320) memattn_item(c, (it - 64) * 8 + wave);
    else gates_item(c, (it - 320) * 8 + wave);
  }
}
DI void phase_p2b(const Ctx& c, u16* lds) {
  for (int it = blockIdx.x; it < 32 + 256; it += gridDim.x) {
    if (it < 32) compress_final_item(c, it, lds);
    else brancha_item(c, (it - 32) >> 2, (it - 32) & 3, lds);
  }
}

constexpr int SM_STAGE = 32768;
constexpr int SM_IMP = 2 * SM_STAGE;
constexpr int SM_UNI = SM_IMP + 16384;
constexpr int SM_TOT = 82944;
constexpr int SM_BAR = 148480;
constexpr int SM_TOTAL = SM_BAR + 16;

struct Stg { u32x4 k[2]; u32x4 v[2]; };
DI void stg_load(Stg& r, const u16* __restrict__ kg, const u16* __restrict__ vg, int tid, bool withV) {
#pragma unroll
  for (int i = 0; i < 2; ++i) r.k[i] = *(const u32x4*)(kg + (i * 512 + tid) * 8);
  if (withV) {
#pragma unroll
    for (int i = 0; i < 2; ++i) r.v[i] = *(const u32x4*)(vg + (i * 512 + tid) * 8);
  }
}
DI void stg_commit(const Stg& r, char* buf, int tid, bool withV) {
#pragma unroll
  for (int i = 0; i < 2; ++i) *(u32x4*)(buf + (i * 512 + tid) * 16) = r.k[i];
  if (withV) {
#pragma unroll
    for (int i = 0; i < 2; ++i) *(u32x4*)(buf + 16384 + (i * 512 + tid) * 16) = r.v[i];
  }
}
DI int pop_bit(unsigned& u0, unsigned& u1, unsigned& u2, unsigned& u3) {
  int j = -1;
  if (u0) { j = __ffs(u0) - 1; u0 &= u0 - 1; }
  else if (u1) { j = 32 + __ffs(u1) - 1; u1 &= u1 - 1; }
  else if (u2) { j = 64 + __ffs(u2) - 1; u2 &= u2 - 1; }
  else if (u3) { j = 96 + __ffs(u3) - 1; u3 &= u3 - 1; }
  return j;
}

DI void nsa_block_item(const Ctx& c, int item, char* smem) {
  const int tid = otid(), lane = tid & 63, wave = tid >> 6, fr = lane & 15, fq = lane >> 4;
  const int g = item & 1, T0 = ((item < 256) ? (255 - (item >> 1)) : ((item - 256) >> 1)) * 32;
  const int t0 = T0 + wave * 4;
  const int tl = fr >> 2, hh = fr & 3, head = g * 4 + hh;
  const int tc = t0 + tl;
  const u16* proj = (const u16*)(c.p.ws + OFF_PROJ);
  float* imp = (float*)(smem + SM_IMP) + wave * 512;
  unsigned* uni = (unsigned*)(smem + SM_UNI);
  bf16x8 qf[4];
#pragma unroll
  for (int ks = 0; ks < 4; ++ks) {
    const bf16x8 raw = *(const bf16x8*)(proj + (size_t)tc * NP + C_BQ + head * 128 + ks * 32 + fq * 8);
    float qs[8];
#pragma unroll
    for (int j = 0; j < 8; ++j) qs[j] = bf2f_s(raw[j]) * SC_LOG2E;
    qf[ks] = pack8(qs);
  }
  constexpr float SC_ONE = 1.f;
  const float g0 = sigmoidf_(bf2f(proj[(size_t)tc * NP + C_BG + head * 3 + 0]));
  const float g1 = sigmoidf_(bf2f(proj[(size_t)tc * NP + C_BG + head * 3 + 1]));
  const float g2 = sigmoidf_(bf2f(proj[(size_t)tc * NP + C_BG + head * 3 + 2]));
  f32x4* tsc = (f32x4*)(smem + SM_TOT) + (wave * 512 + lane);

  const int nmax_c = (tc >= 31) ? ((tc - 31) >> 4) : -1;
  const int nmax_w = (t0 + 3 >= 31) ? ((t0 + 3 - 31) >> 4) : -1;
  const int nmax_b = ((T0 + 31 - 31) >> 4);
  const int ncb = (nmax_b >= 0) ? (nmax_b >> 6) + 1 : 0;
  const u16* kc = (const u16*)(c.p.ws + OFF_KCMP) + (size_t)g * 512 * 128;
  const u16* vct = (const u16*)(c.p.ws + OFF_VCMPT) + (size_t)g * 128 * 512;
  for (int i = lane; i < 512; i += 64) imp[i] = 0.f;
  float mrun = -1e30f, lrun = 0.f;
  __syncthreads();
  Stg sr;
  if (ncb > 0) { stg_load(sr, kc, vct, tid, false); stg_commit(sr, smem, tid, false); }
  for (int jb = 0; jb < ncb; ++jb) {
    __syncthreads();
    if (jb + 1 < ncb) stg_load(sr, kc + (jb + 1) * 8192, vct, tid, false);
    const u16* cur = (const u16*)(smem + (jb & 1) * SM_STAGE);
#pragma unroll
    for (int T = 0; T < 4; ++T) {
      const int n0 = jb * 64 + T * 16;
      if (n0 <= nmax_w) {
        f32x4 sv = zero4();
        const u16* kp = cur + T * 2048 + lane * 8;
#pragma unroll
        for (int ks = 0; ks < 4; ++ks) sv = MFMA16(*(const bf16x8*)(kp + ks * 512), qf[ks], sv);
        float xv[4]; float tm = -1e30f;
#pragma unroll
        for (int r = 0; r < 4; ++r) { xv[r] = sv[r] * SC_ONE; tm = ((n0 + 4 * fq + r) <= nmax_c) ? fmaxf(tm, xv[r]) : tm; }
        const float mn = fmaxf(mrun, tm);
        float la = lrun * fexp2(mrun - mn);
#pragma unroll
        for (int r = 0; r < 4; ++r) la += ((n0 + 4 * fq + r) <= nmax_c) ? fexp2(xv[r] - mn) : 0.f;
        lrun = la; mrun = mn;
      }
    }
    if (jb + 1 < ncb) stg_commit(sr, smem + ((jb + 1) & 1) * SM_STAGE, tid, false);
  }
  __syncthreads();
#pragma unroll
  for (int off = 16; off <= 32; off <<= 1) {
    const float mo = __shfl_xor(mrun, off), lo = __shfl_xor(lrun, off);
    const float mn = fmaxf(mrun, mo);
    lrun = lrun * fexp2(mrun - mn) + lo * fexp2(mo - mn);
    mrun = mn;
  }
  const float invl = lrun > 0.f ? 1.f / lrun : 0.f;
  {
    f32x4 oc[8];
#pragma unroll
    for (int i = 0; i < 8; ++i) oc[i] = zero4();
    if (ncb > 0) { stg_load(sr, kc, vct, tid, true); stg_commit(sr, smem, tid, true); }
    for (int jb = 0; jb < ncb; ++jb) {
      __syncthreads();
      if (jb + 1 < ncb) stg_load(sr, kc + (jb + 1) * 8192, vct + (jb + 1) * 8192, tid, true);
      const u16* cur = (const u16*)(smem + (jb & 1) * SM_STAGE);
#pragma unroll 1
      for (int sub = 0; sub < 2; ++sub) {
        const int n0 = jb * 64 + sub * 32;
        if (n0 <= nmax_w) {
          f32x4 s0 = zero4(), s1 = zero4();
          const u16* kp = cur + sub * 4096 + lane * 8;
          const u16* vp = cur + 8192 + sub * 4096 + lane * 4;
          bf16x8 kf[8];
#pragma unroll
          for (int ks = 0; ks < 4; ++ks) { kf[2 * ks] = *(const bf16x8*)(kp + ks * 512); kf[2 * ks + 1] = *(const bf16x8*)(kp + 2048 + ks * 512); }
#pragma unroll
          for (int ks = 0; ks < 4; ++ks) {
            s0 = MFMA16(kf[2 * ks], qf[ks], s0);
            s1 = MFMA16(kf[2 * ks + 1], qf[ks], s1);
          }
          s16x4 vf[16];
#pragma unroll
          for (int dt = 0; dt < 8; ++dt) { vf[2 * dt] = *(const s16x4*)(vp + dt * 512); vf[2 * dt + 1] = *(const s16x4*)(vp + dt * 512 + 256); }
          float pp[8];
#pragma unroll
          for (int r = 0; r < 4; ++r) {
            pp[r] = ((n0 + 4 * fq + r) <= nmax_c) ? fexp2(s0[r] * SC_ONE - mrun) * invl : 0.f;
            pp[4 + r] = ((n0 + 16 + 4 * fq + r) <= nmax_c) ? fexp2(s1[r] * SC_ONE - mrun) * invl : 0.f;
          }
          float ia[2], ib[2];
#pragma unroll
          for (int i = 0; i < 2; ++i) {
            ia[i] = pp[4 * i] + pp[4 * i + 1] + pp[4 * i + 2] + 0.5f * pp[4 * i + 3];
            ib[i] = 0.5f * pp[4 * i + 3];
            ia[i] += __shfl_xor(ia[i], 1); ia[i] += __shfl_xor(ia[i], 2);
            ib[i] += __shfl_xor(ib[i], 1); ib[i] += __shfl_xor(ib[i], 2);
          }
          if (hh == 0) {
            const int j0 = (n0 >> 2) + fq;
            imp[tl * 128 + j0] += ia[0];
            imp[tl * 128 + j0 + 4] += ia[1];
          }
          asm volatile("s_waitcnt lgkmcnt(0)" ::: "memory");
          if (hh == 0) {
            const int j0 = (n0 >> 2) + fq;
            imp[tl * 128 + j0 + 1] += ib[0];
            if (j0 + 5 < 128) imp[tl * 128 + j0 + 5] += ib[1];
          }
          asm volatile("s_waitcnt lgkmcnt(0)" ::: "memory");
          const bf16x8 pb = pack8(pp);
#pragma unroll
          for (int dt = 0; dt < 8; ++dt) oc[dt] = MFMA16(cat8(vf[2 * dt], vf[2 * dt + 1]), pb, oc[dt]);
        }
      }
      if (jb + 1 < ncb) stg_commit(sr, smem + ((jb + 1) & 1) * SM_STAGE, tid, true);
    }
    __syncthreads();
#pragma unroll
    for (int dt = 0; dt < 8; ++dt) tsc[dt * 64] = oc[dt] * g0;
  }
  asm volatile("s_waitcnt lgkmcnt(0)" ::: "memory");

  uint64_t my_lo = 0, my_hi = 0, un_lo = 0, un_hi = 0;
  const uint64_t lt_mask = (1ull << lane) - 1ull;
  for (int q = 0; q < 4; ++q) {
    const int t = t0 + q, cur = t >> 6;
    unsigned k0, k1;
    {
      const int j = lane;
      float v = (j == 0 || j == cur || j == cur - 1) ? 1e4f : (j <= cur ? imp[q * 128 + j] : 0.f);
      k0 = __float_as_uint(fmaxf(v, 0.f));
    }
    {
      const int j = lane + 64;
      float v = (j == cur || j == cur - 1) ? 1e4f : (j <= cur ? imp[q * 128 + j] : 0.f);
      k1 = __float_as_uint(fmaxf(v, 0.f));
    }
    unsigned T = 0;
    for (int bit = 30; bit >= 0; --bit) {
      const unsigned cand = T | (1u << bit);
      const int cnt = __popcll(__ballot(k0 >= cand)) + __popcll(__ballot(k1 >= cand));
      if (cnt >= 16) T = cand;
    }
    const int ngt = __popcll(__ballot(k0 > T)) + __popcll(__ballot(k1 > T));
    const int need = 16 - ngt;
    const uint64_t eq0 = __ballot(k0 == T), eq1 = __ballot(k1 == T);
    const int rank0 = __popcll(eq0 & lt_mask), rank1 = __popcll(eq0) + __popcll(eq1 & lt_mask);
    uint64_t sel_lo = __ballot(k0 > T || (k0 == T && rank0 < need));
    uint64_t sel_hi = __ballot(k1 > T || (k1 == T && rank1 < need));
    if (cur < 64) { sel_lo &= (2ull << cur) - 1ull; sel_hi = 0; }
    else { sel_hi &= (2ull << (cur - 64)) - 1ull; }
    un_lo |= sel_lo; un_hi |= sel_hi;
    if (tl == q) { my_lo = sel_lo; my_hi = sel_hi; }
  }
  if (lane == 0) {
    uni[wave * 4 + 0] = (unsigned)un_lo; uni[wave * 4 + 1] = (unsigned)(un_lo >> 32);
    uni[wave * 4 + 2] = (unsigned)un_hi; uni[wave * 4 + 3] = (unsigned)(un_hi >> 32);
  }
  __syncthreads();

  {
    ASt st; ast_init(st);
    const u16* ksb = (const u16*)(c.p.ws + OFF_KS) + (size_t)g * 128 * S;
    const u16* vsb = (const u16*)(c.p.ws + OFF_VTS) + (size_t)g * 128 * S;
    unsigned u0 = __builtin_amdgcn_readfirstlane(uni[0] | uni[4] | uni[8] | uni[12] | uni[16] | uni[20] | uni[24] | uni[28]);
    unsigned u1 = __builtin_amdgcn_readfirstlane(uni[1] | uni[5] | uni[9] | uni[13] | uni[17] | uni[21] | uni[25] | uni[29]);
    unsigned u2 = __builtin_amdgcn_readfirstlane(uni[2] | uni[6] | uni[10] | uni[14] | uni[18] | uni[22] | uni[26] | uni[30]);
    unsigned u3 = __builtin_amdgcn_readfirstlane(uni[3] | uni[7] | uni[11] | uni[15] | uni[19] | uni[23] | uni[27] | uni[31]);
    int j = pop_bit(u0, u1, u2, u3);
    int j1 = pop_bit(u0, u1, u2, u3);
    Stg sy;
    if (j >= 0) { stg_load(sr, ksb + (size_t)j * 8192, vsb + (size_t)j * 8192, tid, true); stg_commit(sr, smem, tid, true); }
    if (j1 >= 0) stg_load(sr, ksb + (size_t)j1 * 8192, vsb + (size_t)j1 * 8192, tid, true);
    auto body = [&](int jc, const u16* cur) {
      const bool wneed = (((jc < 64) ? (un_lo >> jc) : (un_hi >> (jc - 64))) & 1ull) != 0;
      if (wneed) {
        const bool selb = (((jc < 64) ? (my_lo >> jc) : (my_hi >> (jc - 64))) & 1ull) != 0;
        if (jc * 64 + 63 <= t0) {
          attn_block<true>(st, qf, cur, lane, 0u, selb, SC_ONE);
        } else {
          unsigned vm = 0;
#pragma unroll
          for (int e = 0; e < 16; ++e) { const int key = jc * 64 + 16 * (e >> 2) + 4 * fq + (e & 3); vm |= (selb && key <= tc) ? (1u << e) : 0u; }
          attn_block<false>(st, qf, cur, lane, vm, false, SC_ONE);
        }
      }
    };
    while (j >= 0) {
      int j2 = pop_bit(u0, u1, u2, u3);
      __syncthreads();
      if (j2 >= 0) stg_load(sy, ksb + (size_t)j2 * 8192, vsb + (size_t)j2 * 8192, tid, true);
      __builtin_amdgcn_sched_barrier(0);
      body(j, (const u16*)smem);
      __builtin_amdgcn_sched_barrier(0);
      if (j1 >= 0) stg_commit(sr, smem + SM_STAGE, tid, true);
      j = j1; j1 = j2;
      if (j < 0) break;
      j2 = pop_bit(u0, u1, u2, u3);
      __syncthreads();
      if (j2 >= 0) stg_load(sr, ksb + (size_t)j2 * 8192, vsb + (size_t)j2 * 8192, tid, true);
      __builtin_amdgcn_sched_barrier(0);
      body(j, (const u16*)(smem + SM_STAGE));
      __builtin_amdgcn_sched_barrier(0);
      if (j1 >= 0) stg_commit(sy, smem, tid, true);
      j = j1; j1 = j2;
    }
    __syncthreads();
    const float inv = ast_inv(st) * g1;
#pragma unroll
    for (int dt = 0; dt < 8; ++dt) tsc[dt * 64] = tsc[dt * 64] + st.o[dt] * inv;
  }
  {
    ASt st; ast_init(st);
    const u16* kwb = (const u16*)(c.p.ws + OFF_KW) + (size_t)g * 128 * S;
    const u16* vwb = (const u16*)(c.p.ws + OFF_VTW) + (size_t)g * 128 * S;
    int jlo = T0 - 511; jlo = jlo < 0 ? 0 : jlo; jlo >>= 6;
    const int jhi = (T0 + 31) >> 6;
    const int nwb = jhi - jlo + 1;
    stg_load(sr, kwb + (size_t)jlo * 8192, vwb + (size_t)jlo * 8192, tid, true); stg_commit(sr, smem, tid, true);
    for (int i = 0; i < nwb; ++i) {
      __syncthreads();
      if (i + 1 < nwb) stg_load(sr, kwb + (size_t)(jlo + i + 1) * 8192, vwb + (size_t)(jlo + i + 1) * 8192, tid, true);
      const u16* cur = (const u16*)(smem + (i & 1) * SM_STAGE);
      {
        const int key0 = (jlo + i) * 64;
        if (key0 <= t0 + 3 && key0 + 575 > t0) {
          if (key0 + 63 <= t0 && key0 + 512 > t0 + 3) {
            attn_block<true>(st, qf, cur, lane, 0u, true, SC_ONE);
          } else {
            unsigned vm = 0;
#pragma unroll
            for (int e = 0; e < 16; ++e) { const int key = key0 + 16 * (e >> 2) + 4 * fq + (e & 3); vm |= (key <= tc && key + 512 > tc) ? (1u << e) : 0u; }
            attn_block<false>(st, qf, cur, lane, vm, false, SC_ONE);
          }
        }
      }
      if (i + 1 < nwb) stg_commit(sr, smem + ((i + 1) & 1) * SM_STAGE, tid, true);
    }
    __syncthreads();
    const float inv = ast_inv(st) * g2;
    u16* ob = (u16*)(c.p.ws + OFF_OB);
#pragma unroll
    for (int dt = 0; dt < 8; ++dt) {
      const f32x4 tv = tsc[dt * 64] + st.o[dt] * inv;
      const int d = head * 128 + dt * 16 + fq * 4;
      const s16x4 z = *(const s16x4*)(proj + (size_t)tc * NP + C_BZ + d);
      f32x4 o;
#pragma unroll
      for (int r = 0; r < 4; ++r) o[r] = tv[r] * siluf_(bf2f_s(z[r]));
      *(s16x4*)(ob + (size_t)tc * 1024 + d) = pack4(o);
    }
  }
#if 0
  {
    {
    f32x4 o;
    *(s16x4*)(ob + (size_t)tc * 1024 + d) = pack4(o);
  }
  }
#endif
}

DI void phase_p3(const Ctx& c, char* smem) {
  for (int it = blockIdx.x; it < 512; it += gridDim.x) nsa_block_item(c, it, smem);
}

DI void phase_merge(const Ctx& c, u16* lds) {
  const int tid = otid(), lane = tid & 63, wave = tid >> 6, wm = wave >> 1, wn = wave & 1, fr = lane & 15, fq = lane >> 4;
  const u16* proj = (const u16*)(c.p.ws + OFF_PROJ);
  u16* mix = (u16*)(c.p.ws + OFF_MIX);
  constexpr int GS = 136;
  for (int it = blockIdx.x; it < 32 * 8; it += gridDim.x) {
    const int nt = it >> 5, mt = it & 31;
    s16x4 totp[4][4];
#pragma unroll 1
    for (int br = 0; br < 3; ++br) {
      const u16* A = (const u16*)(c.p.ws + (br == 0 ? OFF_OA : (br == 1 ? OFF_OB : OFF_OC)));
      const int K = (br == 1) ? 1024 : 512;
      const u16* Bt = (const u16*)(c.lw() + (br == 0 ? LW_WA : (br == 1 ? LW_WB : LW_WC)));
      f32x4 acc[4][4]; zero_acc<4>(acc);
      u32x4 gpre[8];
#pragma unroll
      for (int i = 0; i < 8; ++i) {
        const int cidx = tid + 512 * i, row = cidx >> 4, ch = cidx & 15;
        gpre[i] = *(const u32x4*)(proj + (size_t)(mt * 256 + row) * NP + C_MG + br * 1024 + nt * 128 + ch * 8);
      }
      gemm_mainloop_dma<4>(A + (size_t)mt * 256 * K, K, Bt + (size_t)nt * 128 * K, K, K, acc, lds);
#pragma unroll
      for (int i = 0; i < 8; ++i) {
        const int cidx = tid + 512 * i, row = cidx >> 4, ch = cidx & 15;
        *(u32x4*)(lds + row * GS + ch * 8) = gpre[i];
      }
      __syncthreads();
#pragma unroll
      for (int m = 0; m < 4; ++m)
#pragma unroll
        for (int n = 0; n < 4; ++n) {
          f32x4 t;
#pragma unroll
          for (int r = 0; r < 4; ++r) {
            const float gt = sigmoidf_(bf2f(lds[(wm * 64 + m * 16 + fq * 4 + r) * GS + wn * 64 + n * 16 + fr]));
            t[r] = gt * acc[m][n][r] + (br == 0 ? 0.f : bf2f_s(totp[m][n][r]));
          }
          totp[m][n] = pack4(t);
        }
    }
    __syncthreads();
#pragma unroll
    for (int m = 0; m < 4; ++m)
#pragma unroll
      for (int n = 0; n < 4; ++n)
#pragma unroll
        for (int r = 0; r < 4; ++r) lds[(wm * 64 + m * 16 + fq * 4 + r) * GS + wn * 64 + n * 16 + fr] = (u16)totp[m][n][r];
    __syncthreads();
#pragma unroll
    for (int i = 0; i < 8; ++i) {
      const int cidx = tid + 512 * i, row = cidx >> 4, ch = cidx & 15;
      *(u32x4*)(mix + (size_t)(mt * 256 + row) * 1024 + nt * 128 + ch * 8) = *(const u32x4*)(lds + row * GS + ch * 8);
    }
  }
}

DI void phase_out(const Ctx& c, u16* lds) {
  const int tid = otid(), lane = tid & 63, wave = tid >> 6, wm = wave >> 1, wn = wave & 1, fr = lane & 15, fq = lane >> 4;
  const u16* mix = (const u16*)(c.p.ws + OFF_MIX);
  const u16* wot = (const u16*)(c.lw() + LW_WO);
  const float* xin = (c.l == 0 ? c.p.x : c.p.out) + (size_t)c.b * S * DM;
  float* xout = c.p.out + (size_t)c.b * S * DM;
  float* sC = (float*)lds;
  constexpr int FS = 132;
  for (int it = blockIdx.x; it < 32 * 8; it += gridDim.x) {
    const int nt = it >> 5, mt = it & 31;
    f32x4 acc[4][4]; zero_acc<4>(acc);
    gemm_mainloop_dma<4>(mix + (size_t)mt * 256 * 1024, 1024, wot + (size_t)nt * 128 * 1024, 1024, 1024, acc, lds);
#pragma unroll
    for (int hf = 0; hf < 2; ++hf) {
      __syncthreads();
#pragma unroll
      for (int mm = 0; mm < 2; ++mm)
#pragma unroll
        for (int n = 0; n < 4; ++n)
#pragma unroll
          for (int r = 0; r < 4; ++r)
            sC[(wm * 32 + mm * 16 + fq * 4 + r) * FS + wn * 64 + n * 16 + fr] = acc[hf * 2 + mm][n][r];
      __syncthreads();
#pragma unroll
      for (int i = 0; i < 8; ++i) {
        const int cidx = tid + 512 * i, lr = cidx >> 5, c4 = cidx & 31;
        const int grow = mt * 256 + (lr >> 5) * 64 + (hf * 2 + ((lr >> 4) & 1)) * 16 + (lr & 15);
        const size_t idx = (size_t)grow * DM + nt * 128 + c4 * 4;
        const f32x4 xv = *(const f32x4*)(xin + idx);
        const f32x4 av = *(const f32x4*)(sC + lr * FS + c4 * 4);
        *(f32x4*)(xout + idx) = xv + av;
      }
    }
  }
}

DI void phase_final(const Params& p) {
  const int lane = otid() & 63;
  const int gw = (blockIdx.x * 512 + otid()) >> 6, nw = gridDim.x * 8;
  for (int row = gw; row < NBATCH * S; row += nw) {
    float* x = p.out + (size_t)row * DM;
    float4 v[4]; float ss = 0.f;
#pragma unroll
    for (int i = 0; i < 4; ++i) { v[i] = *(const float4*)(x + i * 256 + lane * 4); ss += v[i].x * v[i].x + v[i].y * v[i].y + v[i].z * v[i].z + v[i].w * v[i].w; }
    ss = wave_sum(ss);
    const float r = rsqrtf(ss * (1.f / 1024.f) + 1e-6f);
#pragma unroll
    for (int i = 0; i < 4; ++i) {
      const float4 g = *(const float4*)(p.fin_gain + i * 256 + lane * 4);
      float4 o; o.x = v[i].x * r * g.x; o.y = v[i].y * r * g.y; o.z = v[i].z * r * g.z; o.w = v[i].w * r * g.w;
      *(float4*)(x + i * 256 + lane * 4) = o;
    }
  }
}

constexpr int NPHASES = 2 + NBATCH * DEPTH * 7 + 1;

__global__ void __launch_bounds__(512, 2) mega(Params p, int ph_begin, int ph_end) {
  __shared__ __attribute__((aligned(16))) char smem[SM_TOTAL];
  cg::grid_group grid = cg::this_grid();
  if (threadIdx.x == 0) *(u32x4*)(smem + SM_BAR) = u32x4{0u, 0u, 0u, 0u};
  __syncthreads();
  const XcdBarrier xb = xcd_barrier_post((unsigned*)(p.ws + OFF_BAR), (volatile LAS unsigned*)(smem + SM_BAR));
  for (int ph = ph_begin; ph < ph_end; ++ph) {
#ifdef DUP_PH0
    if (ph == 0) phase_weights(p, (u16*)smem);
#endif
    if (ph == 0) phase_weights(p, (u16*)smem);
    else if (ph == 1) phase_memkv(p, (u16*)smem);
    else if (ph == NPHASES - 1) phase_final(p);
    else {
      const int q = ph - 2;
      Ctx c; c.p = p; c.b = q / (DEPTH * 7); c.l = (q / 7) % DEPTH;
      const int s = q % 7;

#ifdef DUP_S
      if (s == DUP_S) {
        if (s == 1) phase_proj(c, (u16*)smem);
        else if (s == 2) phase_p2(c, (u16*)smem);
        else if (s == 3) phase_p2b(c, (u16*)smem);
        else if (s == 4) phase_p3(c, smem);
        else if (s == 5) phase_merge(c, (u16*)smem);
      }
#endif
      if (s == 0) phase_norm(c);
      else if (s == 1) phase_proj(c, (u16*)smem);
      else if (s == 2) phase_p2(c, (u16*)smem);
      else if (s == 3) phase_p2b(c, (u16*)smem);
      else if (s == 4) phase_p3(c, smem);
      else if (s == 5) phase_merge(c, (u16*)smem);
      else phase_out(c, (u16*)smem);
    }
    if (ph + 1 < ph_end) { if (ph == 0) grid.sync(); else xcd_barrier(xb); }
  }
}

extern "C" void kernel_launch(void* const* d_in, const int* in_sizes, int n_in, void* d_out, int out_size, void* d_ws, size_t ws_size,
                              hipStream_t stream) {
  Params p{};
  p.x = (const float*)d_in[0]; p.mem = (const float*)d_in[1]; p.pos = (const int*)d_in[2];
  p.norm_gain = (const float*)d_in[3]; p.w_in = (const float*)d_in[4]; p.ln_g = (const float*)d_in[5]; p.ln_b = (const float*)d_in[6];
  p.w_sp = (const float*)d_in[7]; p.b_sp = (const float*)d_in[8];
  p.pe_k = (const float*)d_in[9]; p.w1_k = (const float*)d_in[10]; p.w2_k = (const float*)d_in[11];
  p.pe_v = (const float*)d_in[12]; p.w1_v = (const float*)d_in[13]; p.w2_v = (const float*)d_in[14];
  p.mem_gain = (const float*)d_in[15]; p.w_memkv = (const float*)d_in[16];
  p.w_a = (const float*)d_in[17]; p.w_b = (const float*)d_in[18]; p.w_c = (const float*)d_in[19]; p.w_out = (const float*)d_in[20];
  p.fin_gain = (const float*)d_in[21];
  p.out = (float*)d_out; p.ws = (char*)d_ws;
  static int grid_blocks = 0;
  if (!grid_blocks) {
    int dev = 0, cus = 0, per_cu = 0;
    hipGetDevice(&dev);
    hipDeviceGetAttribute(&cus, hipDeviceAttributeMultiprocessorCount, dev);
    hipOccupancyMaxActiveBlocksPerMultiprocessor(&per_cu, mega, 512, 0);
    if (per_cu > 1) per_cu = 1;
    if (per_cu < 1) per_cu = 1;
    grid_blocks = cus * per_cu;
  }
  hipMemsetAsync((char*)d_ws + OFF_BAR, 0, XCD_BAR_WORDS * 4, stream);
  int pb = 0, pe = NPHASES;
  void* args[] = {&p, &pb, &pe};
  hipError_t e = hipLaunchCooperativeKernel((void*)mega, dim3(grid_blocks), dim3(512), args, 0, stream);
  if (e != hipSuccess) fprintf(stderr, "cooperative launch failed: %s (grid %d)\n", hipGetErrorString(e), grid_blocks);
}
```

```cpp
#include <hip/hip_runtime.h>
#include <hip/hip_cooperative_groups.h>
#include <stdint.h>
#include <cstdio>
namespace cg = cooperative_groups;

typedef unsigned short u16;
using bf16x8 = __attribute__((ext_vector_type(8))) short;
using s16x4  = __attribute__((ext_vector_type(4))) short;
using f32x4  = __attribute__((ext_vector_type(4))) float;
using u32x4  = __attribute__((ext_vector_type(4))) unsigned;
#define DI __device__ __forceinline__
#define MFMA16(a, b, c) __builtin_amdgcn_mfma_f32_16x16x32_bf16((a), (b), (c), 0, 0, 0)

constexpr int DM = 1024;
constexpr int NBATCH = 4;
constexpr int S = 8192;
constexpr int DEPTH = 4;
constexpr int NP = 9344;
constexpr int DIN = 9240;
constexpr int C_AU = 0, C_AV = 512, C_AZ = 1024, C_BQ = 1536, C_BZ = 2560;
constexpr int C_KV = 3584;
constexpr int C_CQ = 5120, C_CZ = 5632, C_MG = 6144, C_BG = 9216;

constexpr size_t MB = 1u << 20;
constexpr size_t SZ_WIN = (size_t)NP * 1024 * 2;
constexpr size_t LW_WIN = 0;
constexpr size_t LW_WA = LW_WIN + SZ_WIN;
constexpr size_t LW_WB = LW_WA + 1 * MB;
constexpr size_t LW_WC = LW_WB + 2 * MB;
constexpr size_t LW_WO = LW_WC + 1 * MB;
constexpr size_t LW_WMKV = LW_WO + 2 * MB;
constexpr size_t LW_W1K = LW_WMKV + 2 * MB;
constexpr size_t LW_W1V = LW_W1K + 1 * MB;
constexpr size_t LW_W2K = LW_W1V + 1 * MB;
constexpr size_t LW_W2V = LW_W2K + 32768;
constexpr size_t LW_WSP = LW_W2V + 32768;
constexpr size_t LW_SIZE = LW_WSP + 131072;
constexpr size_t OFF_MEMN = LW_SIZE * DEPTH;
constexpr size_t OFF_MK = OFF_MEMN + 2 * MB;
constexpr size_t OFF_MVT = OFF_MK + 4 * MB;
constexpr size_t OFF_ROPE = OFF_MVT + 4 * MB;
constexpr size_t OFF_H = OFF_ROPE + 4 * MB;
constexpr size_t OFF_PROJ = OFF_H + 16 * MB;
constexpr size_t SZ_PROJ = (size_t)S * NP * 2;
constexpr size_t OFF_VTS = OFF_PROJ + SZ_PROJ;
constexpr size_t OFF_VTW = OFF_VTS + 4 * MB;
constexpr size_t OFF_KS = OFF_VTW + 4 * MB;
constexpr size_t OFF_KW = OFF_KS + 4 * MB;
constexpr size_t OFF_KCMP = OFF_KW + 4 * MB;
constexpr size_t OFF_VCMPT = OFF_KCMP + 262144;
constexpr size_t OFF_OA = OFF_VCMPT + 262144;
constexpr size_t OFF_OB = OFF_OA + 8 * MB;
constexpr size_t OFF_OC = OFF_OB + 16 * MB;
constexpr size_t OFF_MIX = OFF_OC + 8 * MB;
constexpr size_t OFF_BAR = OFF_MIX + 16 * MB;
constexpr size_t OFF_TOT = OFF_BAR + 16384;
constexpr size_t WS_TOTAL = OFF_TOT + 16 * MB;

struct Params {
  const float* x; const float* mem; const int* pos;
  const float* norm_gain; const float* w_in; const float* ln_g; const float* ln_b;
  const float* w_sp; const float* b_sp;
  const float* pe_k; const float* w1_k; const float* w2_k;
  const float* pe_v; const float* w1_v; const float* w2_v;
  const float* mem_gain; const float* w_memkv;
  const float* w_a; const float* w_b; const float* w_c; const float* w_out; const float* fin_gain;
  float* out; char* ws;
};

DI u16 f2bf(float x) { unsigned u = __float_as_uint(x); u += 0x7fffu + ((u >> 16) & 1u); return (u16)(u >> 16); }
DI float bf2f(u16 h) { return __uint_as_float(((unsigned)h) << 16); }
DI float bf2f_s(short h) { return __uint_as_float(((unsigned)(u16)h) << 16); }
DI float wave_sum(float v) {
#pragma unroll
  for (int o = 32; o > 0; o >>= 1) v += __shfl_xor(v, o);
  return v;
}
DI float sigmoidf_(float x) { return __builtin_amdgcn_rcpf(1.f + __builtin_amdgcn_exp2f(-1.4426950408889634f * x)); }
DI float siluf_(float x) { return x * __builtin_amdgcn_rcpf(1.f + __builtin_amdgcn_exp2f(-1.4426950408889634f * x)); }
using u32x2 = __attribute__((ext_vector_type(2))) unsigned;
DI s16x4 pack4(const f32x4& v) {
  u32x2 r;
  asm("v_cvt_pk_bf16_f32 %0, %2, %3\n\tv_cvt_pk_bf16_f32 %1, %4, %5" : "=&v"(r[0]), "=&v"(r[1]) : "v"(v[0]), "v"(v[1]), "v"(v[2]), "v"(v[3]));
  return __builtin_bit_cast(s16x4, r);
}
DI bf16x8 pack8(const float (&p)[8]) {
  u32x4 r;
  asm volatile("v_cvt_pk_bf16_f32 %0, %4, %5\n\tv_cvt_pk_bf16_f32 %1, %6, %7\n\tv_cvt_pk_bf16_f32 %2, %8, %9\n\tv_cvt_pk_bf16_f32 %3, %10, %11\n\ts_nop 1"
               : "=&v"(r[0]), "=&v"(r[1]), "=&v"(r[2]), "=&v"(r[3])
               : "v"(p[0]), "v"(p[1]), "v"(p[2]), "v"(p[3]), "v"(p[4]), "v"(p[5]), "v"(p[6]), "v"(p[7]));
  return __builtin_bit_cast(bf16x8, r);
}
DI float fexp2(float x) { return __builtin_amdgcn_exp2f(x); }
DI bf16x8 cat8(const s16x4& a, const s16x4& b) { return __builtin_shufflevector(a, b, 0, 1, 2, 3, 4, 5, 6, 7); }
DI int otid() { int t = threadIdx.x; asm volatile("" : "+v"(t)); return t; }
DI f32x4 zero4() { f32x4 z = {0.f, 0.f, 0.f, 0.f}; return z; }

DI int offK(int key, int d) { return (key >> 4) * 2048 + (d >> 5) * 512 + ((((d & 31) >> 3) * 16 + (key & 15)) * 8) + (d & 7); }
DI int offV(int key, int d) { return (key >> 5) * 4096 + (d >> 4) * 512 + (((key & 31) >> 4) * 256) + ((((key & 15) >> 2) * 16 + (d & 15)) * 4) + (key & 3); }

DI int win_col(int n) { return n < 3584 ? n : (n < 9216 ? n + 24 : (n < 9240 ? n - 9216 + 3584 : -1)); }
DI void transpose_tile(const float* __restrict__ src, int ldsrc, int K, u16* __restrict__ dst, int n0, int k0, bool winmode, u16* lds) {
  const int t = otid();
  constexpr int TS = 68;
  __syncthreads();
  {
    const int kk = t >> 4, n4 = (t & 15) * 4;
    const int n = n0 + n4;
    const int col = winmode ? win_col(n) : n;
#pragma unroll
    for (int h = 0; h < 2; ++h) {
      f32x4 v = zero4();
      if (col >= 0) v = *(const f32x4*)(src + (size_t)(k0 + kk + 32 * h) * ldsrc + col);
      *(s16x4*)(lds + (kk + 32 * h) * TS + n4) = pack4(v);
    }
  }
  __syncthreads();
  {
    const int n = t >> 3, k8 = (t & 7) * 8;
    bf16x8 o;
#pragma unroll
    for (int j = 0; j < 8; ++j) o[j] = (short)lds[(k8 + j) * TS + n];
    *(bf16x8*)(dst + (size_t)(n0 + n) * K + k0 + k8) = o;
  }
}

DI void rmsnorm_row_bf16(const float* __restrict__ x, const float* __restrict__ gain, u16* __restrict__ dst) {
  const int lane = otid() & 63;
  float4 v[4]; float ss = 0.f;
#pragma unroll
  for (int i = 0; i < 4; ++i) { v[i] = *(const float4*)(x + i * 256 + lane * 4); ss += v[i].x * v[i].x + v[i].y * v[i].y + v[i].z * v[i].z + v[i].w * v[i].w; }
  ss = wave_sum(ss);
  const float r = rsqrtf(ss * (1.f / 1024.f) + 1e-6f);
#pragma unroll
  for (int i = 0; i < 4; ++i) {
    float4 g = *(const float4*)(gain + i * 256 + lane * 4);
    s16x4 o; o[0] = (short)f2bf(v[i].x * r * g.x); o[1] = (short)f2bf(v[i].y * r * g.y); o[2] = (short)f2bf(v[i].z * r * g.z); o[3] = (short)f2bf(v[i].w * r * g.w);
    *(s16x4*)(dst + i * 256 + lane * 4) = o;
  }
}

constexpr int LDSS = 64;
template <int NF, bool WIN = false>
DI void gemm_mainloop(const u16* __restrict__ A, int lda, const u16* __restrict__ Bt, int ldb, int K, f32x4 (&acc)[4][NF], u16* sA, u16* sB, const float* __restrict__ pe = nullptr) {
  constexpr int GEMM_BUF = 384 * LDSS;
  const int tid = otid(), lane = tid & 63, wave = tid >> 6;
  const int wm = wave >> 1, wn = wave & 1, fr = lane & 15, fq = lane >> 4;
  u32x4 xa[4], xb[NF / 2], ya[4], yb[NF / 2];
  const int lrow = tid >> 3, lkc = (tid & 7) * 8;
  auto gload = [&](u32x4 (&ra)[4], u32x4 (&rb)[NF / 2], int k0) {
#pragma unroll
    for (int i = 0; i < 4; ++i) ra[i] = *(const u32x4*)(A + (size_t)(lrow + 64 * i) * lda + (WIN ? (size_t)(k0 >> 7) * NP + (k0 & 127) : (size_t)k0) + lkc);
#pragma unroll
    for (int i = 0; i < NF / 2; ++i) rb[i] = *(const u32x4*)(Bt + (size_t)(lrow + 64 * i) * ldb + k0 + lkc);
  };
  auto lwrite = [&](u32x4 (&ra)[4], u32x4 (&rb)[NF / 2], int k0, int buf) {
    if (WIN) {
      const float* pp = pe + (k0 >> 7) * 128 + (k0 & 127) + lkc;
      const f32x4 q0 = *(const f32x4*)pp, q1 = *(const f32x4*)(pp + 4);
#pragma unroll
      for (int i = 0; i < 4; ++i) {
        u32x4 w;
        w[0] = (unsigned)f2bf(__uint_as_float(ra[i][0] << 16) + q0[0]) | ((unsigned)f2bf(__uint_as_float(ra[i][0] & 0xffff0000u) + q0[1]) << 16);
        w[1] = (unsigned)f2bf(__uint_as_float(ra[i][1] << 16) + q0[2]) | ((unsigned)f2bf(__uint_as_float(ra[i][1] & 0xffff0000u) + q0[3]) << 16);
        w[2] = (unsigned)f2bf(__uint_as_float(ra[i][2] << 16) + q1[0]) | ((unsigned)f2bf(__uint_as_float(ra[i][2] & 0xffff0000u) + q1[1]) << 16);
        w[3] = (unsigned)f2bf(__uint_as_float(ra[i][3] << 16) + q1[2]) | ((unsigned)f2bf(__uint_as_float(ra[i][3] & 0xffff0000u) + q1[3]) << 16);
        ra[i] = w;
      }
    }
    u16* nA = sA + buf * GEMM_BUF;
    u16* nB = sB + buf * GEMM_BUF;
#pragma unroll
    for (int i = 0; i < 4; ++i) *(u32x4*)(nA + (lrow + 64 * i) * LDSS + (((lkc >> 3) ^ ((lrow >> 1) & 7)) << 3)) = ra[i];
#pragma unroll
    for (int i = 0; i < NF / 2; ++i) *(u32x4*)(nB + (lrow + 64 * i) * LDSS + (((lkc >> 3) ^ ((lrow >> 1) & 7)) << 3)) = rb[i];
  };
  auto compute = [&](int buf) {
    const u16* cA = sA + buf * GEMM_BUF;
    const u16* cB = sB + buf * GEMM_BUF;
    bf16x8 af0[4], bf0[NF], af1[4], bf1[NF];
    const int rs0 = ((fq ^ ((fr >> 1) & 7)) << 3), rs1 = (((4 + fq) ^ ((fr >> 1) & 7)) << 3);
#pragma unroll
    for (int m = 0; m < 4; ++m) af0[m] = *(const bf16x8*)(cA + (wm * 64 + m * 16 + fr) * LDSS + rs0);
#pragma unroll
    for (int n = 0; n < NF; ++n) bf0[n] = *(const bf16x8*)(cB + (wn * (16 * NF) + n * 16 + fr) * LDSS + rs0);
#pragma unroll
    for (int m = 0; m < 4; ++m) af1[m] = *(const bf16x8*)(cA + (wm * 64 + m * 16 + fr) * LDSS + rs1);
#pragma unroll
    for (int n = 0; n < NF; ++n) bf1[n] = *(const bf16x8*)(cB + (wn * (16 * NF) + n * 16 + fr) * LDSS + rs1);
    __builtin_amdgcn_sched_barrier(0);
#pragma unroll
    for (int m = 0; m < 4; ++m)
#pragma unroll
      for (int n = 0; n < NF; ++n) acc[m][n] = MFMA16(af0[m], bf0[n], acc[m][n]);
#pragma unroll
    for (int m = 0; m < 4; ++m)
#pragma unroll
      for (int n = 0; n < NF; ++n) acc[m][n] = MFMA16(af1[m], bf1[n], acc[m][n]);
  };
  gload(xa, xb, 0);
  __syncthreads();
  lwrite(xa, xb, 0, 0);
  gload(xa, xb, 64);
  __syncthreads();
  for (int k0 = 0; k0 < K; k0 += 128) {
    lwrite(xa, xb, k0 + 64, 1);
    if (k0 + 128 < K) gload(ya, yb, k0 + 128);
    __builtin_amdgcn_sched_barrier(0);
    compute(0);
    __syncthreads();
    if (k0 + 128 < K) lwrite(ya, yb, k0 + 128, 0);
    if (k0 + 192 < K) gload(xa, xb, k0 + 192);
    __builtin_amdgcn_sched_barrier(0);
    compute(1);
    __syncthreads();
  }
}
template <int NF, bool WIN = false>
DI void gemm_mainloop1(const u16* __restrict__ A, int lda, const u16* __restrict__ Bt, int ldb, int K, f32x4 (&acc)[4][NF], u16* sA, u16* sB, const float* __restrict__ pe = nullptr) {
  constexpr int GEMM_BUF = 384 * LDSS;
  const int tid = otid(), lane = tid & 63, wave = tid >> 6;
  const int wm = wave >> 1, wn = wave & 1, fr = lane & 15, fq = lane >> 4;
  u32x4 ra[4], rb[NF / 2];
  const int lrow = tid >> 3, lkc = (tid & 7) * 8;
  auto fix_pe = [&](int k0) {
    if (WIN) {
      const float* pp = pe + (k0 >> 7) * 128 + (k0 & 127) + lkc;
      const f32x4 q0 = *(const f32x4*)pp, q1 = *(const f32x4*)(pp + 4);
#pragma unroll
      for (int i = 0; i < 4; ++i) {
        u32x4 w;
        w[0] = (unsigned)f2bf(__uint_as_float(ra[i][0] << 16) + q0[0]) | ((unsigned)f2bf(__uint_as_float(ra[i][0] & 0xffff0000u) + q0[1]) << 16);
        w[1] = (unsigned)f2bf(__uint_as_float(ra[i][1] << 16) + q0[2]) | ((unsigned)f2bf(__uint_as_float(ra[i][1] & 0xffff0000u) + q0[3]) << 16);
        w[2] = (unsigned)f2bf(__uint_as_float(ra[i][2] << 16) + q1[0]) | ((unsigned)f2bf(__uint_as_float(ra[i][2] & 0xffff0000u) + q1[1]) << 16);
        w[3] = (unsigned)f2bf(__uint_as_float(ra[i][3] << 16) + q1[2]) | ((unsigned)f2bf(__uint_as_float(ra[i][3] & 0xffff0000u) + q1[3]) << 16);
        ra[i] = w;
      }
    }
  };
#pragma unroll
  for (int i = 0; i < 4; ++i) ra[i] = *(const u32x4*)(A + (size_t)(lrow + 64 * i) * lda + lkc);
#pragma unroll
  for (int i = 0; i < NF / 2; ++i) rb[i] = *(const u32x4*)(Bt + (size_t)(lrow + 64 * i) * ldb + lkc);
  __syncthreads();
  fix_pe(0);
#pragma unroll
  for (int i = 0; i < 4; ++i) *(u32x4*)(sA + (lrow + 64 * i) * LDSS + (((lkc >> 3) ^ ((lrow >> 1) & 7)) << 3)) = ra[i];
#pragma unroll
  for (int i = 0; i < NF / 2; ++i) *(u32x4*)(sB + (lrow + 64 * i) * LDSS + (((lkc >> 3) ^ ((lrow >> 1) & 7)) << 3)) = rb[i];
  __syncthreads();
  int buf = 0;
  for (int k0 = 0; k0 < K; k0 += 64) {
    const bool more = (k0 + 64 < K);
    if (more) {
#pragma unroll
      for (int i = 0; i < 4; ++i) ra[i] = *(const u32x4*)(A + (size_t)(lrow + 64 * i) * lda + (WIN ? (size_t)((k0 + 64) >> 7) * NP + ((k0 + 64) & 127) : (size_t)(k0 + 64)) + lkc);
#pragma unroll
      for (int i = 0; i < NF / 2; ++i) rb[i] = *(const u32x4*)(Bt + (size_t)(lrow + 64 * i) * ldb + k0 + 64 + lkc);
    }
    const u16* cA = sA + buf * GEMM_BUF;
    const u16* cB = sB + buf * GEMM_BUF;
    __builtin_amdgcn_sched_barrier(0);
#pragma unroll
    for (int ks = 0; ks < 2; ++ks) {
      bf16x8 af[4], bf[NF];
#pragma unroll
      for (int m = 0; m < 4; ++m) af[m] = *(const bf16x8*)(cA + (wm * 64 + m * 16 + fr) * LDSS + (((ks * 4 + fq) ^ ((fr >> 1) & 7)) << 3));
#pragma unroll
      for (int n = 0; n < NF; ++n) bf[n] = *(const bf16x8*)(cB + (wn * (16 * NF) + n * 16 + fr) * LDSS + (((ks * 4 + fq) ^ ((fr >> 1) & 7)) << 3));
#pragma unroll
      for (int m = 0; m < 4; ++m)
#pragma unroll
        for (int n = 0; n < NF; ++n) acc[m][n] = MFMA16(af[m], bf[n], acc[m][n]);
    }
    __builtin_amdgcn_sched_barrier(0);
    if (more) {
      fix_pe(k0 + 64);
      u16* nA = sA + (buf ^ 1) * GEMM_BUF;
      u16* nB = sB + (buf ^ 1) * GEMM_BUF;
#pragma unroll
      for (int i = 0; i < 4; ++i) *(u32x4*)(nA + (lrow + 64 * i) * LDSS + (((lkc >> 3) ^ ((lrow >> 1) & 7)) << 3)) = ra[i];
#pragma unroll
      for (int i = 0; i < NF / 2; ++i) *(u32x4*)(nB + (lrow + 64 * i) * LDSS + (((lkc >> 3) ^ ((lrow >> 1) & 7)) << 3)) = rb[i];
    }
    __syncthreads();
    buf ^= 1;
  }
}
template <int NF>
DI void gemm_mainloop_dma(const u16* __restrict__ A, int lda, const u16* __restrict__ Bt, int ldb, int K, f32x4 (&acc)[4][NF], u16* sbase) {
  constexpr int STG = 384 * LDSS;
  const int tid = otid(), lane = tid & 63, wave = tid >> 6;
  const int wm = wave >> 1, wn = wave & 1, fr = lane & 15, fq = lane >> 4;
  const int lrow = tid >> 3, lc = tid & 7;
  const int gsw = ((lc ^ ((lrow >> 1) & 7)) << 3);
  const u16* ga = A + (size_t)lrow * lda + gsw;
  const u16* gb = Bt + (size_t)lrow * ldb + gsw;
  auto issue = [&](int t, int buf) {
    u16* da = sbase + buf * STG + lrow * LDSS + lc * 8;
#pragma unroll
    for (int i = 0; i < 4; ++i)
      __builtin_amdgcn_global_load_lds((const unsigned*)(ga + (size_t)(64 * i) * lda + t * 64), (unsigned*)(da + (64 * i) * LDSS), 16, 0, 0);
#pragma unroll
    for (int i = 0; i < NF / 2; ++i)
      __builtin_amdgcn_global_load_lds((const unsigned*)(gb + (size_t)(64 * i) * ldb + t * 64), (unsigned*)(da + (256 + 64 * i) * LDSS), 16, 0, 0);
  };
  const int rs0 = ((fq ^ ((fr >> 1) & 7)) << 3), rs1 = (((4 + fq) ^ ((fr >> 1) & 7)) << 3);
  const int nk = K >> 6;
  __syncthreads();
  issue(0, 0);
  issue(1, 1);
  int buf = 0;
  for (int k = 0; k < nk; ++k) {
    if (k + 1 < nk) { if (NF == 4) asm volatile("s_waitcnt vmcnt(6)" ::: "memory"); else asm volatile("s_waitcnt vmcnt(5)" ::: "memory"); }
    else asm volatile("s_waitcnt vmcnt(0)" ::: "memory");
    asm volatile("s_waitcnt lgkmcnt(0)" ::: "memory");
    __builtin_amdgcn_s_barrier();
    if (k + 2 < nk) issue(k + 2, buf == 0 ? 2 : buf - 1);
    const u16* cA = sbase + buf * STG;
    const u16* cB = cA + 256 * LDSS;
    bf16x8 af0[4], bf0[NF], af1[4], bf1[NF];
#pragma unroll
    for (int m = 0; m < 4; ++m) af0[m] = *(const bf16x8*)(cA + (wm * 64 + m * 16 + fr) * LDSS + rs0);
#pragma unroll
    for (int n = 0; n < NF; ++n) bf0[n] = *(const bf16x8*)(cB + (wn * (16 * NF) + n * 16 + fr) * LDSS + rs0);
#pragma unroll
    for (int m = 0; m < 4; ++m) af1[m] = *(const bf16x8*)(cA + (wm * 64 + m * 16 + fr) * LDSS + rs1);
#pragma unroll
    for (int n = 0; n < NF; ++n) bf1[n] = *(const bf16x8*)(cB + (wn * (16 * NF) + n * 16 + fr) * LDSS + rs1);
#pragma unroll
    for (int m = 0; m < 4; ++m)
#pragma unroll
      for (int n = 0; n < NF; ++n) acc[m][n] = MFMA16(af0[m], bf0[n], acc[m][n]);
#pragma unroll
    for (int m = 0; m < 4; ++m)
#pragma unroll
      for (int n = 0; n < NF; ++n) acc[m][n] = MFMA16(af1[m], bf1[n], acc[m][n]);
    buf = (buf == 2) ? 0 : buf + 1;
  }
  __syncthreads();
}
DI void gemm_mainloop_big_dma(const u16* __restrict__ A, int lda, const u16* __restrict__ Bt, int ldb, int K, f32x4 (&acc)[8][4], u16* sbase) {
  constexpr int STG = 512 * LDSS;
  const int tid = otid(), lane = tid & 63, wave = tid >> 6;
  const int wm = wave >> 2, wn = wave & 3, fr = lane & 15, fq = lane >> 4;
  const int lrow = tid >> 3, lc = tid & 7;
  const int gsw = ((lc ^ ((lrow >> 1) & 7)) << 3);
  auto issue = [&](int t, int buf) {
    int lr = lrow; asm volatile("" : "+v"(lr));
    const u16* ga = A + (size_t)lr * lda + gsw;
    const u16* gb = Bt + (size_t)lr * ldb + gsw;
    u16* da = sbase + buf * STG + lr * LDSS + lc * 8;
#pragma unroll
    for (int i = 0; i < 4; ++i)
      __builtin_amdgcn_global_load_lds((const unsigned*)(ga + (size_t)(64 * i) * lda + t * 64), (unsigned*)(da + (64 * i) * LDSS), 16, 0, 0);
#pragma unroll
    for (int i = 0; i < 4; ++i)
      __builtin_amdgcn_global_load_lds((const unsigned*)(gb + (size_t)(64 * i) * ldb + t * 64), (unsigned*)(da + (256 + 64 * i) * LDSS), 16, 0, 0);
  };
  const int nk = K >> 6;
  __syncthreads();
  issue(0, 0);
  for (int k = 0; k < nk; ++k) {
    asm volatile("s_waitcnt vmcnt(0)" ::: "memory");
    asm volatile("s_waitcnt lgkmcnt(0)" ::: "memory");
    __builtin_amdgcn_s_barrier();
    if (k + 1 < nk) issue(k + 1, (k + 1) & 1);
    const u16* cA = sbase + (k & 1) * STG;
    const u16* cB = cA + 256 * LDSS;
#pragma unroll
    for (int ks = 0; ks < 2; ++ks) {
      const int rsw = (((ks * 4 + fq) ^ ((fr >> 1) & 7)) << 3);
      bf16x8 bf[4];
#pragma unroll
      for (int n = 0; n < 4; ++n) bf[n] = *(const bf16x8*)(cB + (wn * 64 + n * 16 + fr) * LDSS + rsw);
#pragma unroll
      for (int mh = 0; mh < 2; ++mh) {
        bf16x8 af[4];
#pragma unroll
        for (int m = 0; m < 4; ++m) af[m] = *(const bf16x8*)(cA + (wm * 128 + (mh * 4 + m) * 16 + fr) * LDSS + rsw);
#pragma unroll
        for (int m = 0; m < 4; ++m)
#pragma unroll
          for (int n = 0; n < 4; ++n) acc[mh * 4 + m][n] = MFMA16(af[m], bf[n], acc[mh * 4 + m][n]);
      }
    }
  }
  __syncthreads();
}
template <int NF>
DI void zero_acc(f32x4 (&acc)[4][NF]) {
#pragma unroll
  for (int m = 0; m < 4; ++m)
#pragma unroll
    for (int n = 0; n < NF; ++n) acc[m][n] = zero4();
}

struct ASt { f32x4 o[8]; float m; float l; };
DI void ast_init(ASt& s) {
#pragma unroll
  for (int i = 0; i < 8; ++i) s.o[i] = zero4();
  s.m = -1e30f; s.l = 0.f;
}
DI void attn_step(ASt& st, const bf16x8 (&qf)[4], const u16* __restrict__ kp, const u16* __restrict__ vp, unsigned vmask, float sc) {
  bf16x8 kf[8];
#pragma unroll
  for (int ks = 0; ks < 4; ++ks) { kf[2 * ks] = *(const bf16x8*)(kp + ks * 512); kf[2 * ks + 1] = *(const bf16x8*)(kp + 2048 + ks * 512); }
  f32x4 s0 = zero4(), s1 = zero4();
#pragma unroll
  for (int ks = 0; ks < 4; ++ks) {
    s0 = MFMA16(kf[2 * ks], qf[ks], s0);
    s1 = MFMA16(kf[2 * ks + 1], qf[ks], s1);
  }
  s16x4 vf[16];
#pragma unroll
  for (int dt = 0; dt < 8; ++dt) { vf[2 * dt] = *(const s16x4*)(vp + dt * 512); vf[2 * dt + 1] = *(const s16x4*)(vp + dt * 512 + 256); }
  float p[8];
#pragma unroll
  for (int r = 0; r < 4; ++r) { p[r] = s0[r] * sc; p[4 + r] = s1[r] * sc; }
  float tmax = -1e30f;
#pragma unroll
  for (int i = 0; i < 8; ++i) tmax = ((vmask >> i) & 1u) ? fmaxf(tmax, p[i]) : tmax;
  tmax = fmaxf(tmax, __shfl_xor(tmax, 16));
  tmax = fmaxf(tmax, __shfl_xor(tmax, 32));
  const float mn = fmaxf(st.m, tmax);
  const float alpha = exp2f(st.m - mn);
  st.m = mn;
  float ps = 0.f;
#pragma unroll
  for (int i = 0; i < 8; ++i) { p[i] = ((vmask >> i) & 1u) ? exp2f(p[i] - mn) : 0.f; ps += p[i]; }
  st.l = st.l * alpha + ps;
  bf16x8 pb;
#pragma unroll
  for (int i = 0; i < 8; ++i) pb[i] = (short)f2bf(p[i]);
#pragma unroll
  for (int dt = 0; dt < 8; ++dt) st.o[dt] = st.o[dt] * alpha;
#pragma unroll
  for (int dt = 0; dt < 8; ++dt) st.o[dt] = MFMA16(cat8(vf[2 * dt], vf[2 * dt + 1]), pb, st.o[dt]);
}
template <bool FULL>
DI void attn_block(ASt& st, const bf16x8 (&qf)[4], const u16* __restrict__ cur, int lane, unsigned vmask, bool col, float sc) {
  const u16* kp = cur + lane * 8;
  const u16* vp = cur + 8192 + lane * 4;
  f32x4 s[4];
#pragma unroll
  for (int h = 0; h < 2; ++h) {
    bf16x8 kf[8];
#pragma unroll
    for (int ks = 0; ks < 4; ++ks) { kf[2 * ks] = *(const bf16x8*)(kp + (2 * h) * 2048 + ks * 512); kf[2 * ks + 1] = *(const bf16x8*)(kp + (2 * h + 1) * 2048 + ks * 512); }
    f32x4 a = zero4(), b = zero4();
#pragma unroll
    for (int ks = 0; ks < 4; ++ks) { a = MFMA16(kf[2 * ks], qf[ks], a); b = MFMA16(kf[2 * ks + 1], qf[ks], b); }
    s[2 * h] = a; s[2 * h + 1] = b;
  }
  s16x4 vf[16];
#pragma unroll
  for (int dt = 0; dt < 8; ++dt) { vf[2 * dt] = *(const s16x4*)(vp + dt * 512); vf[2 * dt + 1] = *(const s16x4*)(vp + dt * 512 + 256); }
  float p[16];
  float tmax = -1e30f;
  if (FULL) {
#pragma unroll
    for (int i = 0; i < 16; ++i) { p[i] = s[i >> 2][i & 3] * sc; tmax = fmaxf(tmax, p[i]); }
    tmax = col ? tmax : -1e30f;
  } else {
#pragma unroll
    for (int i = 0; i < 16; ++i) { p[i] = s[i >> 2][i & 3] * sc; tmax = ((vmask >> i) & 1u) ? fmaxf(tmax, p[i]) : tmax; }
  }
  if (__any(tmax > st.m + 8.f)) {
    float tm = fmaxf(tmax, __shfl_xor(tmax, 16));
    tm = fmaxf(tm, __shfl_xor(tm, 32));
    const float mn = fmaxf(st.m, tm);
    const float alpha = fexp2(st.m - mn);
    st.m = mn;
    st.l *= alpha;
#pragma unroll
    for (int dt = 0; dt < 8; ++dt) st.o[dt] = st.o[dt] * alpha;
  }
  float ps = 0.f;
  if (FULL) {
#pragma unroll
    for (int i = 0; i < 16; ++i) { p[i] = col ? fexp2(p[i] - st.m) : 0.f; ps += p[i]; }
  } else {
#pragma unroll
    for (int i = 0; i < 16; ++i) { p[i] = ((vmask >> i) & 1u) ? fexp2(p[i] - st.m) : 0.f; ps += p[i]; }
  }
  st.l += ps;
  const float pa[8] = {p[0], p[1], p[2], p[3], p[4], p[5], p[6], p[7]};
  const float pc[8] = {p[8], p[9], p[10], p[11], p[12], p[13], p[14], p[15]};
  const bf16x8 pb0 = pack8(pa), pb1 = pack8(pc);
#pragma unroll
  for (int dt = 0; dt < 8; ++dt) st.o[dt] = MFMA16(cat8(vf[2 * dt], vf[2 * dt + 1]), pb0, st.o[dt]);
#pragma unroll
  for (int dt = 0; dt < 8; ++dt) { vf[2 * dt] = *(const s16x4*)(vp + 4096 + dt * 512); vf[2 * dt + 1] = *(const s16x4*)(vp + 4096 + dt * 512 + 256); }
#pragma unroll
  for (int dt = 0; dt < 8; ++dt) st.o[dt] = MFMA16(cat8(vf[2 * dt], vf[2 * dt + 1]), pb1, st.o[dt]);
}
DI float ast_inv(const ASt& st) {
  float l = st.l;
  l += __shfl_xor(l, 16);
  l += __shfl_xor(l, 32);
  return l > 0.f ? 1.f / l : 0.f;
}

constexpr float SC_LOG2E = 0.08838834764831845f * 1.4426950408889634f;

#define XB_TMO      128
#define XB_XCNT(j)  (256  + 64 * (j))
#define XB_XSUB(j)  (1280 + 64 * (j))
#define XB_XGEN(j)  (2304 + 64 * (j))
#define XB_TOP      3328
#define XB_TOPGEN   3392
#define XCD_BAR_WORDS 3456
#define XB_SPIN_CAP (1u << 22)
#define LAS __attribute__((address_space(3)))
DI unsigned xb_ld(unsigned* p)              { return __hip_atomic_load(p, __ATOMIC_RELAXED, __HIP_MEMORY_SCOPE_AGENT); }
DI unsigned xb_add(unsigned* p, unsigned v) { return __hip_atomic_fetch_add(p, v, __ATOMIC_RELAXED, __HIP_MEMORY_SCOPE_AGENT); }
DI unsigned xb_xcc_id() { return (unsigned)__builtin_amdgcn_s_getreg((3 << 11) | 20) & 0xFu; }
#define XB_SPIN(cond, bar) do { unsigned _sp = 0; while (cond) { __builtin_amdgcn_s_sleep(1); \
    if ((++_sp & 255u) == 0u) { if (xb_ld(&(bar)[XB_TMO])) break; if (_sp > XB_SPIN_CAP) { atomicAdd(&(bar)[XB_TMO], 1u); break; } } } } while (0)
struct XcdBarrier { unsigned* bar; unsigned x; volatile LAS unsigned* st; };
DI XcdBarrier xcd_barrier_post(unsigned* bar, volatile LAS unsigned* st) {
  XcdBarrier b; b.bar = bar; b.x = xb_xcc_id(); b.st = st;
  if (threadIdx.x == 0) (void)xb_add(&bar[XB_XCNT(b.x)], 1u);
  return b;
}
DI void xcd_barrier_complete(unsigned* bar, unsigned x, unsigned& nloc, unsigned& nx) {
  const unsigned G = gridDim.x * gridDim.y * gridDim.z;
  unsigned sum, cnt, mine, sp = 0u;
  for (;;) {
    sum = 0u; cnt = 0u; mine = 0u;
#pragma unroll
    for (unsigned j = 0; j < 16; ++j) { const unsigned c = xb_ld(&bar[XB_XCNT(j)]); sum += c; cnt += (c > 0u) ? 1u : 0u; mine = (j == x) ? c : mine; }
    if (sum == G) break;
    __builtin_amdgcn_s_sleep(1);
    if ((++sp & 255u) == 0u) { if (xb_ld(&bar[XB_TMO])) break; if (sp > XB_SPIN_CAP) { atomicAdd(&bar[XB_TMO], 1u); break; } }
  }
  nloc = mine > 0u ? mine : 1u; nx = cnt > 0u ? cnt : 1u;
}
DI void xcd_barrier(const XcdBarrier& b) {
  asm volatile("s_waitcnt vmcnt(0)" ::: "memory");
  __syncthreads();
  if (threadIdx.x == 0) {
    unsigned* bar = b.bar;
    __builtin_amdgcn_s_waitcnt(0);
    unsigned nloc = b.st[0], nx = b.st[1];
    if (nloc == 0u) { xcd_barrier_complete(bar, b.x, nloc, nx); b.st[0] = nloc; b.st[1] = nx; }
    const unsigned old = xb_add(&bar[XB_XSUB(b.x)], 1u);
    const unsigned gen = old / nloc;
    if (old + 1u == (gen + 1u) * nloc) {
      __builtin_amdgcn_fence(__ATOMIC_RELEASE, "agent");
      asm volatile("s_waitcnt vmcnt(0)" ::: "memory");
      const unsigned og = xb_add(&bar[XB_TOP], 1u);
      const unsigned tg = og / nx;
      if (og + 1u == (tg + 1u) * nx) xb_add(&bar[XB_TOPGEN], 1u);
      else XB_SPIN(xb_ld(&bar[XB_TOPGEN]) == tg, bar);
      __builtin_amdgcn_fence(__ATOMIC_ACQUIRE, "agent");
      xb_add(&bar[XB_XGEN(b.x)], 1u);
      asm volatile("s_waitcnt vmcnt(0)" ::: "memory");
    } else {
      XB_SPIN(xb_ld(&bar[XB_XGEN(b.x)]) == gen, bar);
      __builtin_amdgcn_fence(__ATOMIC_ACQUIRE, "agent");
      asm volatile("s_waitcnt vmcnt(0)" ::: "memory");
    }
  }
  __syncthreads();
}

struct Ctx {
  Params p; int b; int l;
  DI char* lw() const { return p.ws + LW_SIZE * (size_t)l; }
};

DI float rope_inv_freq(int f) {
  switch (f) {
    case 0: return 1.000000000e+00f;
    case 1: return 4.403665960e-01f;
    case 2: return 1.939227432e-01f;
    case 3: return 8.539710194e-02f;
    case 4: return 3.760603070e-02f;
    case 5: return 1.656044088e-02f;
    case 6: return 7.292664610e-03f;
    case 7: return 3.211446106e-03f;
    case 8: return 1.414213562e-03f;
    case 9: return 6.227724371e-04f;
    case 10: return 2.742481884e-04f;
    case 11: return 1.207697351e-04f;
    case 12: return 5.318295734e-05f;
    case 13: return 2.341999971e-05f;
    case 14: return 1.031338525e-05f;
    case 15: return 4.541670478e-06f;
    default: return 0.f;
  }
}
DI void phase_weights(const Params& p, u16* lds) {
  constexpr int PER_LAYER = 2336 + 128 + 256 + 128 + 256 + 256 + 128 + 128 + 4 + 4;
  for (int it = blockIdx.x; it < PER_LAYER * DEPTH; it += gridDim.x) {
    const int l = it / PER_LAYER; int r = it % PER_LAYER;
    char* lw = p.ws + LW_SIZE * (size_t)l;
    const float* src; int ldsrc, K, ntn; u16* dst; bool wm = false;
    if (r < 2336) { src = p.w_in + (size_t)l * 1024 * DIN; ldsrc = DIN; K = 1024; ntn = 146; dst = (u16*)(lw + LW_WIN); wm = true; }
    else if ((r -= 2336) < 128) { src = p.w_a + (size_t)l * 512 * 1024; ldsrc = 1024; K = 512; ntn = 16; dst = (u16*)(lw + LW_WA); }
    else if ((r -= 128) < 256) { src = p.w_b + (size_t)l * 1024 * 1024; ldsrc = 1024; K = 1024; ntn = 16; dst = (u16*)(lw + LW_WB); }
    else if ((r -= 256) < 128) { src = p.w_c + (size_t)l * 512 * 1024; ldsrc = 1024; K = 512; ntn = 16; dst = (u16*)(lw + LW_WC); }
    else if ((r -= 128) < 256) { src = p.w_out + (size_t)l * 1024 * 1024; ldsrc = 1024; K = 1024; ntn = 16; dst = (u16*)(lw + LW_WO); }
    else if ((r -= 256) < 256) { src = p.w_memkv + (size_t)l * 1024 * 1024; ldsrc = 1024; K = 1024; ntn = 16; dst = (u16*)(lw + LW_WMKV); }
    else if ((r -= 256) < 128) { src = p.w1_k + (size_t)l * 4096 * 128; ldsrc = 128; K = 4096; ntn = 2; dst = (u16*)(lw + LW_W1K); }
    else if ((r -= 128) < 128) { src = p.w1_v + (size_t)l * 4096 * 128; ldsrc = 128; K = 4096; ntn = 2; dst = (u16*)(lw + LW_W1V); }
    else if ((r -= 128) < 4) { src = p.w2_k + (size_t)l * 128 * 128; ldsrc = 128; K = 128; ntn = 2; dst = (u16*)(lw + LW_W2K); }
    else { r -= 4; src = p.w2_v + (size_t)l * 128 * 128; ldsrc = 128; K = 128; ntn = 2; dst = (u16*)(lw + LW_W2V); }
    const int nt = r % ntn, kt = r / ntn;
    transpose_tile(src, ldsrc, K, dst, nt * 64, kt * 64, wm, lds);
  }
  const int gtid = blockIdx.x * 512 + otid(), gstride = gridDim.x * 512;
  for (int i = gtid; i < DEPTH * 65536; i += gstride) {
    const int l = i >> 16, e = i & 65535, t = (e >> 7) & 127, s = e & 127;
    const float v = (s <= t) ? p.w_sp[i] : 0.f;
    ((u16*)(p.ws + LW_SIZE * (size_t)l + LW_WSP))[e] = f2bf(v);
  }
  float2* rt = (float2*)(p.ws + OFF_ROPE);
  for (int i = gtid; i < NBATCH * S * 16; i += gstride) {
    const int f = i & 15, bs = i >> 4;
    const float inv = rope_inv_freq(f);
    const float ang = (float)p.pos[bs] * inv;
    float sn, cs; sincosf(ang, &sn, &cs);
    rt[i] = make_float2(cs, sn);
  }
  const int gw = (blockIdx.x * 512 + otid()) >> 6, nw = gridDim.x * 8;
  for (int row = gw; row < NBATCH * 256; row += nw)
    rmsnorm_row_bf16(p.mem + (size_t)row * 1024, p.mem_gain, (u16*)(p.ws + OFF_MEMN) + (size_t)row * 1024);
}

DI void phase_memkv(const Params& p, u16* lds) {
  const int tid = otid(), lane = tid & 63, wave = tid >> 6, wm = wave >> 1, wn = wave & 1, fr = lane & 15, fq = lane >> 4;
  for (int it = blockIdx.x; it < DEPTH * 32; it += gridDim.x) {
    const int l = it >> 5, mt = (it >> 3) & 3, nt = it & 7;
    f32x4 acc[4][4]; zero_acc<4>(acc);
    gemm_mainloop1<4>((const u16*)(p.ws + OFF_MEMN) + (size_t)mt * 256 * 1024, 1024,
                  (const u16*)(p.ws + LW_SIZE * (size_t)l + LW_WMKV) + (size_t)nt * 128 * 1024, 1024, 1024, acc, lds, lds + 256 * LDSS);
    const int b = mt, kv = nt >> 2, h = nt & 3;
    u16* mk = (u16*)(p.ws + OFF_MK + (size_t)l * MB) + (size_t)(b * 4 + h) * 256 * 128;
    u16* mvt = (u16*)(p.ws + OFF_MVT + (size_t)l * MB) + (size_t)(b * 4 + h) * 128 * 256;
#pragma unroll
    for (int m = 0; m < 4; ++m)
#pragma unroll
      for (int n = 0; n < 4; ++n) {
        const int mrow = wm * 64 + m * 16 + fq * 4;
        const int d = wn * 64 + n * 16 + fr;
        if (kv == 0) {
#pragma unroll
          for (int r = 0; r < 4; ++r) mk[offK(mrow + r, d)] = f2bf(acc[m][n][r]);
        } else {
          *(s16x4*)(mvt + offV(mrow, d)) = pack4(acc[m][n]);
        }
      }
  }
}

DI void phase_norm(const Ctx& c) {
  const float* xin = (c.l == 0 ? c.p.x : c.p.out) + (size_t)c.b * S * DM;
  const float* gain = c.p.norm_gain + c.l * DM;
  u16* h = (u16*)(c.p.ws + OFF_H);
  const int gw = (blockIdx.x * 512 + otid()) >> 6, nw = gridDim.x * 8;
  for (int row = gw; row < S; row += nw) rmsnorm_row_bf16(xin + (size_t)row * DM, gain, h + (size_t)row * DM);
}

DI void phase_proj(const Ctx& c, u16* lds) {
  const int tid = otid(), lane = tid & 63, wave = tid >> 6, wm = wave >> 1, wn = wave & 1, fr = lane & 15, fq = lane >> 4;
  const u16* h = (const u16*)(c.p.ws + OFF_H);
  const u16* wint = (const u16*)(c.lw() + LW_WIN);
  u16* proj = (u16*)(c.p.ws + OFF_PROJ);
  const float2* rt = (const float2*)(c.p.ws + OFF_ROPE) + (size_t)c.b * S * 16;
  {
    const int wmB = wave >> 2, wn4 = wave & 3;
  for (int it = blockIdx.x; it < 32 * 32; it += gridDim.x) {
    const int nt2 = it >> 5, mt = it & 31;
    f32x4 acc[8][4];
#pragma unroll
    for (int m = 0; m < 8; ++m)
#pragma unroll
      for (int n = 0; n < 4; ++n) acc[m][n] = zero4();
    gemm_mainloop_big_dma(h + (size_t)mt * 256 * 1024, 1024, wint + (size_t)nt2 * 256 * 1024, 1024, 1024, acc, lds);
    int fr2 = fr, fq2 = fq; asm volatile("" : "+v"(fr2), "+v"(fq2));
    const int wv = otid() >> 6;
    const int nt = nt2 * 2 + ((wv & 3) >> 1);
    const int wn = wv & 1;
    const int row_base = mt * 256 + (wv >> 2) * 128;
    if (nt < 73) {
      const bool rope = (nt >= 12 && nt < 20) || nt == 28 || nt == 29 || nt == 32 || nt == 33 || nt == 36 || nt == 37;
      if (rope && wn == 0) {
#pragma unroll
        for (int m = 0; m < 8; ++m)
#pragma unroll
          for (int r = 0; r < 4; ++r) {
            const int tok = row_base + m * 16 + fq2 * 4 + r;
            const float2 cs = rt[(size_t)tok * 16 + fr2];
            const float t1 = acc[m][0][r], t2 = acc[m][1][r];
            acc[m][0][r] = t1 * cs.x - t2 * cs.y;
            acc[m][1][r] = t2 * cs.x + t1 * cs.y;
          }
      }
      if (nt == 34 || nt == 35 || nt == 38 || nt == 39) {
        u16* dst = (u16*)(c.p.ws + (nt < 36 ? OFF_VTS : OFF_VTW)) + (size_t)((nt & 1) * 128) * S;
#pragma unroll
        for (int m = 0; m < 8; ++m)
#pragma unroll
          for (int n = 0; n < 4; ++n) {
            const int d = wn * 64 + n * 16 + fr2, tok = row_base + m * 16 + fq2 * 4;
            *(s16x4*)(dst + offV(tok, d)) = pack4(acc[m][n]);
          }
      } else if (nt == 32 || nt == 33 || nt == 36 || nt == 37) {
        u16* dst = (u16*)(c.p.ws + (nt < 36 ? OFF_KS : OFF_KW)) + (size_t)((nt & 1) * 128) * S;
#pragma unroll
        for (int m = 0; m < 8; ++m)
#pragma unroll
          for (int n = 0; n < 4; ++n) {
            const s16x4 v = pack4(acc[m][n]);
#pragma unroll
            for (int r = 0; r < 4; ++r) dst[offK(row_base + m * 16 + fq2 * 4 + r, wn * 64 + n * 16 + fr2)] = (u16)v[r];
          }
      } else {
#pragma unroll
        for (int m = 0; m < 8; ++m)
#pragma unroll
          for (int n = 0; n < 4; ++n) {
            const s16x4 v = pack4(acc[m][n]);
#pragma unroll
            for (int r = 0; r < 4; ++r) proj[(size_t)(row_base + m * 16 + fq2 * 4 + r) * NP + nt * 128 + wn * 64 + n * 16 + fr2] = (u16)v[r];
          }
      }
    }
  }
  }
  {
  const int tid = otid(), lane = tid & 63, wave = tid >> 6, wm = wave >> 1, wn = wave & 1, fr = lane & 15, fq = lane >> 4;
  for (int it = blockIdx.x; it < 32 * 8; it += gridDim.x) {
    const int nt = 64 + (it >> 5), mt = it & 31;
    f32x4 acc[4][4]; zero_acc<4>(acc);
    gemm_mainloop_dma<4>(h + (size_t)mt * 256 * 1024, 1024, wint + (size_t)nt * 128 * 1024, 1024, 1024, acc, lds);
    const int row_base = mt * 256 + wm * 64;
    const bool rope = (nt >= 12 && nt < 20) || nt == 28 || nt == 29 || nt == 32 || nt == 33 || nt == 36 || nt == 37;
    if (rope && wn == 0) {
#pragma unroll
      for (int m = 0; m < 4; ++m)
#pragma unroll
        for (int r = 0; r < 4; ++r) {
          const int tok = row_base + m * 16 + fq * 4 + r;
          const float2 cs = rt[(size_t)tok * 16 + fr];
          const float t1 = acc[m][0][r], t2 = acc[m][1][r];
          acc[m][0][r] = t1 * cs.x - t2 * cs.y;
          acc[m][1][r] = t2 * cs.x + t1 * cs.y;
        }
    }
    if (nt == 34 || nt == 35 || nt == 38 || nt == 39) {
      u16* dst = (u16*)(c.p.ws + (nt < 36 ? OFF_VTS : OFF_VTW)) + (size_t)((nt & 1) * 128) * S;
#pragma unroll
      for (int m = 0; m < 4; ++m)
#pragma unroll
        for (int n = 0; n < 4; ++n) {
          const int d = wn * 64 + n * 16 + fr, tok = row_base + m * 16 + fq * 4;
          *(s16x4*)(dst + offV(tok, d)) = pack4(acc[m][n]);
        }
    } else {
      constexpr int PS = 136;
#pragma unroll
      for (int m = 0; m < 4; ++m)
#pragma unroll
        for (int n = 0; n < 4; ++n) {
          const s16x4 v = pack4(acc[m][n]);
#pragma unroll
          for (int r = 0; r < 4; ++r) lds[(wm * 64 + m * 16 + fq * 4 + r) * PS + wn * 64 + n * 16 + fr] = (u16)v[r];
        }
      __syncthreads();
      const bool kblk = (nt == 32 || nt == 33 || nt == 36 || nt == 37);
      u16* kdst = (u16*)(c.p.ws + (nt < 36 ? OFF_KS : OFF_KW)) + (size_t)((nt & 1) * 128) * S;
#pragma unroll
      for (int i = 0; i < 8; ++i) {
        const int cidx = tid + 512 * i, row = cidx >> 4, ch = cidx & 15;
        const u32x4 v = *(const u32x4*)(lds + row * PS + ch * 8);
        if (kblk) *(u32x4*)(kdst + offK(mt * 256 + row, ch * 8)) = v;
        else *(u32x4*)(proj + (size_t)(mt * 256 + row) * NP + nt * 128 + ch * 8) = v;
      }
    }
  }
  }
}

DI void brancha_item(const Ctx& c, int ch, int g, u16* vnT) {
  const int tid = otid(), lane = tid & 63, wave = tid >> 6, wm = wave >> 1, wn = wave & 1, fr = lane & 15, fq = lane >> 4;
  const u16* proj = (const u16*)(c.p.ws + OFF_PROJ);
  const int tk0 = ch * 128;
  constexpr int VS = 136;
  __syncthreads();
  {
    const float* lg = c.p.ln_g + c.l * 512 + lane * 8;
    const float* lb = c.p.ln_b + c.l * 512 + lane * 8;
    float gg[8], bb[8];
#pragma unroll
    for (int j = 0; j < 8; ++j) { gg[j] = lg[j]; bb[j] = lb[j]; }
#pragma unroll 8
    for (int rr = 0; rr < 16; ++rr) {
      const int row = wave * 16 + rr;
      const bf16x8 raw = *(const bf16x8*)(proj + (size_t)(tk0 + row) * NP + C_AV + lane * 8);
      float xv[8]; float sm = 0.f;
#pragma unroll
      for (int j = 0; j < 8; ++j) { xv[j] = bf2f_s(raw[j]); sm += xv[j]; }
      const float mean = wave_sum(sm) * (1.f / 512.f);
      float sq = 0.f;
#pragma unroll
      for (int j = 0; j < 8; ++j) { xv[j] -= mean; sq += xv[j] * xv[j]; }
      const float rstd = rsqrtf(wave_sum(sq) * (1.f / 512.f) + 1e-6f);
      if ((lane >> 4) == g) {
#pragma unroll
        for (int j = 0; j < 8; ++j) vnT[((lane & 15) * 8 + j) * VS + row] = f2bf(xv[j] * rstd * gg[j] + bb[j]);
      }
    }
  }
  __syncthreads();
  const u16* wsp = (const u16*)(c.lw() + LW_WSP) + (size_t)g * 16384;
  f32x4 acc[2][4];
#pragma unroll
  for (int m = 0; m < 2; ++m)
#pragma unroll
    for (int n = 0; n < 4; ++n) acc[m][n] = zero4();
#pragma unroll
  for (int ks = 0; ks < 4; ++ks) {
    bf16x8 af[2], bf[4];
#pragma unroll
    for (int m = 0; m < 2; ++m) af[m] = *(const bf16x8*)(wsp + (wm * 32 + m * 16 + fr) * 128 + ks * 32 + fq * 8);
#pragma unroll
    for (int n = 0; n < 4; ++n) bf[n] = *(const bf16x8*)(vnT + (wn * 64 + n * 16 + fr) * VS + ks * 32 + fq * 8);
#pragma unroll
    for (int m = 0; m < 2; ++m)
#pragma unroll
      for (int n = 0; n < 4; ++n) acc[m][n] = MFMA16(af[m], bf[n], acc[m][n]);
  }
  const float* bsp = c.p.b_sp + c.l * 512 + g * 128;
  u16* oa = (u16*)(c.p.ws + OFF_OA);
#pragma unroll 1
  for (int pass = 0; pass < 2; ++pass) {
    __syncthreads();
#pragma unroll
    for (int i = 0; i < 4; ++i) {
      const int cidx = tid + 512 * i, row = cidx >> 4, ch = cidx & 15;
      *(u32x4*)(vnT + row * VS + ch * 8) = *(const u32x4*)(proj + (size_t)(tk0 + row) * NP + (pass == 0 ? C_AU : C_AZ) + g * 128 + ch * 8);
    }
    __syncthreads();
#pragma unroll
    for (int m = 0; m < 2; ++m)
#pragma unroll
      for (int r = 0; r < 4; ++r) {
        const int t = wm * 32 + m * 16 + fq * 4 + r;
        const float bs = (pass == 0) ? bsp[t] : 0.f;
#pragma unroll
        for (int n = 0; n < 4; ++n) {
          const float v = bf2f(vnT[t * VS + wn * 64 + n * 16 + fr]);
          acc[m][n][r] = (pass == 0) ? (acc[m][n][r] + bs) * v : acc[m][n][r] * siluf_(v);
        }
      }
  }
  __syncthreads();
#pragma unroll
  for (int m = 0; m < 2; ++m)
#pragma unroll
    for (int n = 0; n < 4; ++n) {
      const s16x4 v = pack4(acc[m][n]);
#pragma unroll
      for (int r = 0; r < 4; ++r) vnT[(wm * 32 + m * 16 + fq * 4 + r) * VS + wn * 64 + n * 16 + fr] = (u16)v[r];
    }
  __syncthreads();
#pragma unroll
  for (int i = 0; i < 4; ++i) {
    const int cidx = tid + 512 * i, row = cidx >> 4, ch = cidx & 15;
    *(u32x4*)(oa + (size_t)(tk0 + row) * 512 + g * 128 + ch * 8) = *(const u32x4*)(vnT + row * VS + ch * 8);
  }
}

DI void memattn_item(const Ctx& c, int item) {
  const int lane = otid() & 63, fr = lane & 15, fq = lane >> 4;
  const int h = item & 3, tt = item >> 2;
  const int tc = tt * 16 + fr;
  const u16* proj = (const u16*)(c.p.ws + OFF_PROJ);
  bf16x8 qf[4];
#pragma unroll
  for (int ks = 0; ks < 4; ++ks) {
    const bf16x8 raw = *(const bf16x8*)(proj + (size_t)tc * NP + C_CQ + h * 128 + ks * 32 + fq * 8);
    float qs[8];
#pragma unroll
    for (int j = 0; j < 8; ++j) qs[j] = bf2f_s(raw[j]) * SC_LOG2E;
    qf[ks] = pack8(qs);
  }
  const u16* mk = (const u16*)(c.p.ws + OFF_MK + (size_t)c.l * MB) + (size_t)(c.b * 4 + h) * 256 * 128;
  const u16* mvt = (const u16*)(c.p.ws + OFF_MVT + (size_t)c.l * MB) + (size_t)(c.b * 4 + h) * 128 * 256;
  ASt st; ast_init(st);
  for (int key0 = 0; key0 < 256; key0 += 32)
    attn_step(st, qf, mk + (key0 >> 4) * 2048 + lane * 8, mvt + (key0 >> 5) * 4096 + lane * 4, 0xFFu, 1.f);
  const float inv = ast_inv(st);
  u16* oc = (u16*)(c.p.ws + OFF_OC);
#pragma unroll
  for (int dt = 0; dt < 8; ++dt) {
    const int d = h * 128 + dt * 16 + fq * 4;
    const s16x4 z = *(const s16x4*)(proj + (size_t)tc * NP + C_CZ + d);
    f32x4 o;
#pragma unroll
    for (int r = 0; r < 4; ++r) o[r] = st.o[dt][r] * inv * siluf_(bf2f_s(z[r]));
    *(s16x4*)(oc + (size_t)tc * 512 + d) = pack4(o);
  }
}

DI void compress_split_item(const Ctx& c, int idx, u16* lds) {
  const int tid = otid(), lane = tid & 63, wave = tid >> 6, wm = wave >> 1, wn = wave & 1, fr = lane & 15, fq = lane >> 4;
  const int kv = idx >> 5, g = (idx >> 4) & 1, mt = (idx >> 3) & 1, ks = idx & 7;
  const u16* A = (const u16*)(c.p.ws + OFF_PROJ) + C_KV + kv * 256 + g * 128 + (size_t)(mt * 256) * 16 * NP + (size_t)(ks * 4) * NP;
  const u16* w1t = (const u16*)(c.lw() + (kv ? LW_W1V : LW_W1K)) + ks * 512;
  const float* pe = (kv ? c.p.pe_v : c.p.pe_k) + (size_t)c.l * 32 * 128 + ks * 512;
  f32x4 acc[4][4]; zero_acc<4>(acc);
  gemm_mainloop<4, true>(A, 16 * NP, w1t, 4096, 512, acc, lds, lds + 256 * LDSS, pe);
  float* part = (float*)(c.p.ws + OFF_TOT) + (size_t)(((ks * 2 + kv) * 2 + g) * 512 + mt * 256) * 128;
#pragma unroll
  for (int m = 0; m < 4; ++m)
#pragma unroll
    for (int n = 0; n < 4; ++n)
#pragma unroll
      for (int r = 0; r < 4; ++r) part[(size_t)(wm * 64 + m * 16 + fq * 4 + r) * 128 + wn * 64 + n * 16 + fr] = acc[m][n][r];
}
DI void compress_final_item(const Ctx& c, int idx, u16* lds) {
  const int tid = otid(), lane = tid & 63, wave = tid >> 6, wm = wave >> 1, wn = wave & 1, fr = lane & 15, fq = lane >> 4;
  const int kv = idx >> 4, g = (idx >> 3) & 1, sl = idx & 7;
  const u16* w2t = (const u16*)(c.lw() + (kv ? LW_W2V : LW_W2K));
  constexpr int HS = 136;
  __syncthreads();
#pragma unroll
  for (int i = 0; i < 4; ++i) {
    const int cidx = tid + 512 * i, row = cidx >> 5, c4 = cidx & 31;
    f32x4 sum = zero4();
#pragma unroll
    for (int ks = 0; ks < 8; ++ks)
      sum += *(const f32x4*)((const float*)(c.p.ws + OFF_TOT) + (size_t)(((ks * 2 + kv) * 2 + g) * 512 + sl * 64 + row) * 128 + c4 * 4);
    f32x4 hv;
#pragma unroll
    for (int r = 0; r < 4; ++r) hv[r] = siluf_(sum[r]);
    *(s16x4*)(lds + row * HS + c4 * 4) = pack4(hv);
  }
  __syncthreads();
  f32x4 acc[4];
#pragma unroll
  for (int n = 0; n < 4; ++n) acc[n] = zero4();
#pragma unroll
  for (int ks = 0; ks < 4; ++ks) {
    const bf16x8 af = *(const bf16x8*)(lds + (wm * 16 + fr) * HS + ks * 32 + fq * 8);
#pragma unroll
    for (int n = 0; n < 4; ++n) {
      const bf16x8 bf = *(const bf16x8*)(w2t + (wn * 64 + n * 16 + fr) * 128 + ks * 32 + fq * 8);
      acc[n] = MFMA16(af, bf, acc[n]);
    }
  }
  u16* kc = (u16*)(c.p.ws + OFF_KCMP) + (size_t)g * 512 * 128;
  u16* vct = (u16*)(c.p.ws + OFF_VCMPT) + (size_t)g * 128 * 512;
#pragma unroll
  for (int n = 0; n < 4; ++n) {
    const int nrow = sl * 64 + wm * 16 + fq * 4, d = wn * 64 + n * 16 + fr;
    if (kv == 0) {
#pragma unroll
      for (int r = 0; r < 4; ++r) kc[offK(nrow + r, d)] = f2bf(acc[n][r]);
    } else {
      *(s16x4*)(vct + offV(nrow, d)) = pack4(acc[n]);
    }
  }
}

DI void gates_item(const Ctx& c, int item) {
  const int lane = otid() & 63, fr = lane & 15, fq = lane >> 4;
  const u16* h = (const u16*)(c.p.ws + OFF_H) + (size_t)(item * 16 + fr) * 1024 + fq * 8;
  const u16* w = (const u16*)(c.lw() + LW_WIN) + (size_t)(C_BG + fr) * 1024 + fq * 8;
  f32x4 a0 = zero4(), a1 = zero4();
#pragma unroll 4
  for (int ks = 0; ks < 32; ++ks) {
    const bf16x8 af = *(const bf16x8*)(h + ks * 32);
    const bf16x8 b0 = *(const bf16x8*)(w + ks * 32);
    const bf16x8 b1 = *(const bf16x8*)(w + 16 * 1024 + ks * 32);
    a0 = MFMA16(af, b0, a0);
    a1 = MFMA16(af, b1, a1);
  }
  u16* proj = (u16*)(c.p.ws + OFF_PROJ);
#pragma unroll
  for (int r = 0; r < 4; ++r) {
    proj[(size_t)(item * 16 + fq * 4 + r) * NP + C_BG + fr] = f2bf(a0[r]);
    proj[(size_t)(item * 16 + fq * 4 + r) * NP + C_BG + 16 + fr] = f2bf(a1[r]);
  }
}

DI void phase_p2(const Ctx& c, u16* lds) {
  const int wave = otid() >> 6;
  for (int it = blockIdx.x; it < 64 + 256 + 64; it += gridDim.x) {
    if (it < 64) compress_split_item(c, it, lds);
    else if (it < 320) memattn_item(c, (it - 64) * 8 + wave);
    else gates_item(c, (it - 320) * 8 + wave);
  }
}
DI void phase_p2b(const Ctx& c, u16* lds) {
  for (int it = blockIdx.x; it < 32 + 256; it += gridDim.x) {
    if (it < 32) compress_final_item(c, it, lds);
    else brancha_item(c, (it - 32) >> 2, (it - 32) & 3, lds);
  }
}

constexpr int SM_STAGE = 32768;
constexpr int SM_IMP = 2 * SM_STAGE;
constexpr int SM_UNI = SM_IMP + 16384;
constexpr int SM_TOT = 82944;
constexpr int SM_BAR = 148480;
constexpr int SM_TOTAL = SM_BAR + 16;

struct Stg { u32x4 k[2]; u32x4 v[2]; };
DI void stg_load(Stg& r, const u16* __restrict__ kg, const u16* __restrict__ vg, int tid, bool withV) {
#pragma unroll
  for (int i = 0; i < 2; ++i) r.k[i] = *(const u32x4*)(kg + (i * 512 + tid) * 8);
  if (withV) {
#pragma unroll
    for (int i = 0; i < 2; ++i) r.v[i] = *(const u32x4*)(vg + (i * 512 + tid) * 8);
  }
}
DI void stg_commit(const Stg& r, char* buf, int tid, bool withV) {
#pragma unroll
  for (int i = 0; i < 2; ++i) *(u32x4*)(buf + (i * 512 + tid) * 16) = r.k[i];
  if (withV) {
#pragma unroll
    for (int i = 0; i < 2; ++i) *(u32x4*)(buf + 16384 + (i * 512 + tid) * 16) = r.v[i];
  }
}
DI int pop_bit(unsigned& u0, unsigned& u1, unsigned& u2, unsigned& u3) {
  int j = -1;
  if (u0) { j = __ffs(u0) - 1; u0 &= u0 - 1; }
  else if (u1) { j = 32 + __ffs(u1) - 1; u1 &= u1 - 1; }
  else if (u2) { j = 64 + __ffs(u2) - 1; u2 &= u2 - 1; }
  else if (u3) { j = 96 + __ffs(u3) - 1; u3 &= u3 - 1; }
  return j;
}

DI void nsa_block_item(const Ctx& c, int item, char* smem) {
  const int tid = otid(), lane = tid & 63, wave = tid >> 6, fr = lane & 15, fq = lane >> 4;
  const int g = item & 1, T0 = ((item < 256) ? (255 - (item >> 1)) : ((item - 256) >> 1)) * 32;
  const int t0 = T0 + wave * 4;
  const int tl = fr >> 2, hh = fr & 3, head = g * 4 + hh;
  const int tc = t0 + tl;
  const u16* proj = (const u16*)(c.p.ws + OFF_PROJ);
  float* imp = (float*)(smem + SM_IMP) + wave * 512;
  unsigned* uni = (unsigned*)(smem + SM_UNI);
  bf16x8 qf[4];
#pragma unroll
  for (int ks = 0; ks < 4; ++ks) {
    const bf16x8 raw = *(const bf16x8*)(proj + (size_t)tc * NP + C_BQ + head * 128 + ks * 32 + fq * 8);
    float qs[8];
#pragma unroll
    for (int j = 0; j < 8; ++j) qs[j] = bf2f_s(raw[j]) * SC_LOG2E;
    qf[ks] = pack8(qs);
  }
  constexpr float SC_ONE = 1.f;
  const float g0 = sigmoidf_(bf2f(proj[(size_t)tc * NP + C_BG + head * 3 + 0]));
  const float g1 = sigmoidf_(bf2f(proj[(size_t)tc * NP + C_BG + head * 3 + 1]));
  const float g2 = sigmoidf_(bf2f(proj[(size_t)tc * NP + C_BG + head * 3 + 2]));
  f32x4* tsc = (f32x4*)(smem + SM_TOT) + (wave * 512 + lane);

  const int nmax_c = (tc >= 31) ? ((tc - 31) >> 4) : -1;
  const int nmax_w = (t0 + 3 >= 31) ? ((t0 + 3 - 31) >> 4) : -1;
  const int nmax_b = ((T0 + 31 - 31) >> 4);
  const int ncb = (nmax_b >= 0) ? (nmax_b >> 6) + 1 : 0;
  const u16* kc = (const u16*)(c.p.ws + OFF_KCMP) + (size_t)g * 512 * 128;
  const u16* vct = (const u16*)(c.p.ws + OFF_VCMPT) + (size_t)g * 128 * 512;
  for (int i = lane; i < 512; i += 64) imp[i] = 0.f;
  float mrun = -1e30f, lrun = 0.f;
  __syncthreads();
  Stg sr;
  if (ncb > 0) { stg_load(sr, kc, vct, tid, false); stg_commit(sr, smem, tid, false); }
  for (int jb = 0; jb < ncb; ++jb) {
    __syncthreads();
    if (jb + 1 < ncb) stg_load(sr, kc + (jb + 1) * 8192, vct, tid, false);
    const u16* cur = (const u16*)(smem + (jb & 1) * SM_STAGE);
#pragma unroll
    for (int T = 0; T < 4; ++T) {
      const int n0 = jb * 64 + T * 16;
      if (n0 <= nmax_w) {
        f32x4 sv = zero4();
        const u16* kp = cur + T * 2048 + lane * 8;
#pragma unroll
        for (int ks = 0; ks < 4; ++ks) sv = MFMA16(*(const bf16x8*)(kp + ks * 512), qf[ks], sv);
        float xv[4]; float tm = -1e30f;
#pragma unroll
        for (int r = 0; r < 4; ++r) { xv[r] = sv[r] * SC_ONE; tm = ((n0 + 4 * fq + r) <= nmax_c) ? fmaxf(tm, xv[r]) : tm; }
        const float mn = fmaxf(mrun, tm);
        float la = lrun * fexp2(mrun - mn);
#pragma unroll
        for (int r = 0; r < 4; ++r) la += ((n0 + 4 * fq + r) <= nmax_c) ? fexp2(xv[r] - mn) : 0.f;
        lrun = la; mrun = mn;
      }
    }
    if (jb + 1 < ncb) stg_commit(sr, smem + ((jb + 1) & 1) * SM_STAGE, tid, false);
  }
  __syncthreads();
#pragma unroll
  for (int off = 16; off <= 32; off <<= 1) {
    const float mo = __shfl_xor(mrun, off), lo = __shfl_xor(lrun, off);
    const float mn = fmaxf(mrun, mo);
    lrun = lrun * fexp2(mrun - mn) + lo * fexp2(mo - mn);
    mrun = mn;
  }
  const float invl = lrun > 0.f ? 1.f / lrun : 0.f;
  {
    f32x4 oc[8];
#pragma unroll
    for (int i = 0; i < 8; ++i) oc[i] = zero4();
    if (ncb > 0) { stg_load(sr, kc, vct, tid, true); stg_commit(sr, smem, tid, true); }
    for (int jb = 0; jb < ncb; ++jb) {
      __syncthreads();
      if (jb + 1 < ncb) stg_load(sr, kc + (jb + 1) * 8192, vct + (jb + 1) * 8192, tid, true);
      const u16* cur = (const u16*)(smem + (jb & 1) * SM_STAGE);
#pragma unroll 1
      for (int sub = 0; sub < 2; ++sub) {
        const int n0 = jb * 64 + sub * 32;
        if (n0 <= nmax_w) {
          f32x4 s0 = zero4(), s1 = zero4();
          const u16* kp = cur + sub * 4096 + lane * 8;
          const u16* vp = cur + 8192 + sub * 4096 + lane * 4;
          bf16x8 kf[8];
#pragma unroll
          for (int ks = 0; ks < 4; ++ks) { kf[2 * ks] = *(const bf16x8*)(kp + ks * 512); kf[2 * ks + 1] = *(const bf16x8*)(kp + 2048 + ks * 512); }
#pragma unroll
          for (int ks = 0; ks < 4; ++ks) {
            s0 = MFMA16(kf[2 * ks], qf[ks], s0);
            s1 = MFMA16(kf[2 * ks + 1], qf[ks], s1);
          }
          s16x4 vf[16];
#pragma unroll
          for (int dt = 0; dt < 8; ++dt) { vf[2 * dt] = *(const s16x4*)(vp + dt * 512); vf[2 * dt + 1] = *(const s16x4*)(vp + dt * 512 + 256); }
          float pp[8];
#pragma unroll
          for (int r = 0; r < 4; ++r) {
            pp[r] = ((n0 + 4 * fq + r) <= nmax_c) ? fexp2(s0[r] * SC_ONE - mrun) * invl : 0.f;
            pp[4 + r] = ((n0 + 16 + 4 * fq + r) <= nmax_c) ? fexp2(s1[r] * SC_ONE - mrun) * invl : 0.f;
          }
          float ia[2], ib[2];
#pragma unroll
          for (int i = 0; i < 2; ++i) {
            ia[i] = pp[4 * i] + pp[4 * i + 1] + pp[4 * i + 2] + 0.5f * pp[4 * i + 3];
            ib[i] = 0.5f * pp[4 * i + 3];
            ia[i] += __shfl_xor(ia[i], 1); ia[i] += __shfl_xor(ia[i], 2);
            ib[i] += __shfl_xor(ib[i], 1); ib[i] += __shfl_xor(ib[i], 2);
          }
          if (hh == 0) {
            const int j0 = (n0 >> 2) + fq;
            imp[tl * 128 + j0] += ia[0];
            imp[tl * 128 + j0 + 4] += ia[1];
          }
          asm volatile("s_waitcnt lgkmcnt(0)" ::: "memory");
          if (hh == 0) {
            const int j0 = (n0 >> 2) + fq;
            imp[tl * 128 + j0 + 1] += ib[0];
            if (j0 + 5 < 128) imp[tl * 128 + j0 + 5] += ib[1];
          }
          asm volatile("s_waitcnt lgkmcnt(0)" ::: "memory");
          const bf16x8 pb = pack8(pp);
#pragma unroll
          for (int dt = 0; dt < 8; ++dt) oc[dt] = MFMA16(cat8(vf[2 * dt], vf[2 * dt + 1]), pb, oc[dt]);
        }
      }
      if (jb + 1 < ncb) stg_commit(sr, smem + ((jb + 1) & 1) * SM_STAGE, tid, true);
    }
    __syncthreads();
#pragma unroll
    for (int dt = 0; dt < 8; ++dt) tsc[dt * 64] = oc[dt] * g0;
  }
  asm volatile("s_waitcnt lgkmcnt(0)" ::: "memory");

  uint64_t my_lo = 0, my_hi = 0, un_lo = 0, un_hi = 0;
  const uint64_t lt_mask = (1ull << lane) - 1ull;
  for (int q = 0; q < 4; ++q) {
    const int t = t0 + q, cur = t >> 6;
    unsigned k0, k1;
    {
      const int j = lane;
      float v = (j == 0 || j == cur || j == cur - 1) ? 1e4f : (j <= cur ? imp[q * 128 + j] : 0.f);
      k0 = __float_as_uint(fmaxf(v, 0.f));
    }
    {
      const int j = lane + 64;
      float v = (j == cur || j == cur - 1) ? 1e4f : (j <= cur ? imp[q * 128 + j] : 0.f);
      k1 = __float_as_uint(fmaxf(v, 0.f));
    }
    unsigned T = 0;
    for (int bit = 30; bit >= 0; --bit) {
      const unsigned cand = T | (1u << bit);
      const int cnt = __popcll(__ballot(k0 >= cand)) + __popcll(__ballot(k1 >= cand));
      if (cnt >= 16) T = cand;
    }
    const int ngt = __popcll(__ballot(k0 > T)) + __popcll(__ballot(k1 > T));
    const int need = 16 - ngt;
    const uint64_t eq0 = __ballot(k0 == T), eq1 = __ballot(k1 == T);
    const int rank0 = __popcll(eq0 & lt_mask), rank1 = __popcll(eq0) + __popcll(eq1 & lt_mask);
    uint64_t sel_lo = __ballot(k0 > T || (k0 == T && rank0 < need));
    uint64_t sel_hi = __ballot(k1 > T || (k1 == T && rank1 < need));
    if (cur < 64) { sel_lo &= (2ull << cur) - 1ull; sel_hi = 0; }
    else { sel_hi &= (2ull << (cur - 64)) - 1ull; }
    un_lo |= sel_lo; un_hi |= sel_hi;
    if (tl == q) { my_lo = sel_lo; my_hi = sel_hi; }
  }
  if (lane == 0) {
    uni[wave * 4 + 0] = (unsigned)un_lo; uni[wave * 4 + 1] = (unsigned)(un_lo >> 32);
    uni[wave * 4 + 2] = (unsigned)un_hi; uni[wave * 4 + 3] = (unsigned)(un_hi >> 32);
  }
  __syncthreads();

  {
    ASt st; ast_init(st);
    const u16* ksb = (const u16*)(c.p.ws + OFF_KS) + (size_t)g * 128 * S;
    const u16* vsb = (const u16*)(c.p.ws + OFF_VTS) + (size_t)g * 128 * S;
    unsigned u0 = __builtin_amdgcn_readfirstlane(uni[0] | uni[4] | uni[8] | uni[12] | uni[16] | uni[20] | uni[24] | uni[28]);
    unsigned u1 = __builtin_amdgcn_readfirstlane(uni[1] | uni[5] | uni[9] | uni[13] | uni[17] | uni[21] | uni[25] | uni[29]);
    unsigned u2 = __builtin_amdgcn_readfirstlane(uni[2] | uni[6] | uni[10] | uni[14] | uni[18] | uni[22] | uni[26] | uni[30]);
    unsigned u3 = __builtin_amdgcn_readfirstlane(uni[3] | uni[7] | uni[11] | uni[15] | uni[19] | uni[23] | uni[27] | uni[31]);
    int j = pop_bit(u0, u1, u2, u3);
    int j1 = pop_bit(u0, u1, u2, u3);
    Stg sy;
    if (j >= 0) { stg_load(sr, ksb + (size_t)j * 8192, vsb + (size_t)j * 8192, tid, true); stg_commit(sr, smem, tid, true); }
    if (j1 >= 0) stg_load(sr, ksb + (size_t)j1 * 8192, vsb + (size_t)j1 * 8192, tid, true);
    auto body = [&](int jc, const u16* cur) {
      const bool wneed = (((jc < 64) ? (un_lo >> jc) : (un_hi >> (jc - 64))) & 1ull) != 0;
      if (wneed) {
        const bool selb = (((jc < 64) ? (my_lo >> jc) : (my_hi >> (jc - 64))) & 1ull) != 0;
        if (jc * 64 + 63 <= t0) {
          attn_block<true>(st, qf, cur, lane, 0u, selb, SC_ONE);
        } else {
          unsigned vm = 0;
#pragma unroll
          for (int e = 0; e < 16; ++e) { const int key = jc * 64 + 16 * (e >> 2) + 4 * fq + (e & 3); vm |= (selb && key <= tc) ? (1u << e) : 0u; }
          attn_block<false>(st, qf, cur, lane, vm, false, SC_ONE);
        }
      }
    };
    while (j >= 0) {
      int j2 = pop_bit(u0, u1, u2, u3);
      __syncthreads();
      if (j2 >= 0) stg_load(sy, ksb + (size_t)j2 * 8192, vsb + (size_t)j2 * 8192, tid, true);
      __builtin_amdgcn_sched_barrier(0);
      body(j, (const u16*)smem);
      __builtin_amdgcn_sched_barrier(0);
      if (j1 >= 0) stg_commit(sr, smem + SM_STAGE, tid, true);
      j = j1; j1 = j2;
      if (j < 0) break;
      j2 = pop_bit(u0, u1, u2, u3);
      __syncthreads();
      if (j2 >= 0) stg_load(sr, ksb + (size_t)j2 * 8192, vsb + (size_t)j2 * 8192, tid, true);
      __builtin_amdgcn_sched_barrier(0);
      body(j, (const u16*)(smem + SM_STAGE));
      __builtin_amdgcn_sched_barrier(0);
      if (j1 >= 0) stg_commit(sy, smem, tid, true);
      j = j1; j1 = j2;
    }
    __syncthreads();
    const float inv = ast_inv(st) * g1;
#pragma unroll
    for (int dt = 0; dt < 8; ++dt) tsc[dt * 64] = tsc[dt * 64] + st.o[dt] * inv;
  }
  {
    ASt st; ast_init(st);
    const u16* kwb = (const u16*)(c.p.ws + OFF_KW) + (size_t)g * 128 * S;
    const u16* vwb = (const u16*)(c.p.ws + OFF_VTW) + (size_t)g * 128 * S;
    int jlo = T0 - 511; jlo = jlo < 0 ? 0 : jlo; jlo >>= 6;
    const int jhi = (T0 + 31) >> 6;
    const int nwb = jhi - jlo + 1;
    stg_load(sr, kwb + (size_t)jlo * 8192, vwb + (size_t)jlo * 8192, tid, true); stg_commit(sr, smem, tid, true);
    for (int i = 0; i < nwb; ++i) {
      __syncthreads();
      if (i + 1 < nwb) stg_load(sr, kwb + (size_t)(jlo + i + 1) * 8192, vwb + (size_t)(jlo + i + 1) * 8192, tid, true);
      const u16* cur = (const u16*)(smem + (i & 1) * SM_STAGE);
      {
        const int key0 = (jlo + i) * 64;
        if (key0 <= t0 + 3 && key0 + 575 > t0) {
          if (key0 + 63 <= t0 && key0 + 512 > t0 + 3) {
            attn_block<true>(st, qf, cur, lane, 0u, true, SC_ONE);
          } else {
            unsigned vm = 0;
#pragma unroll
            for (int e = 0; e < 16; ++e) { const int key = key0 + 16 * (e >> 2) + 4 * fq + (e & 3); vm |= (key <= tc && key + 512 > tc) ? (1u << e) : 0u; }
            attn_block<false>(st, qf, cur, lane, vm, false, SC_ONE);
          }
        }
      }
      if (i + 1 < nwb) stg_commit(sr, smem + ((i + 1) & 1) * SM_STAGE, tid, true);
    }
    __syncthreads();
    const float inv = ast_inv(st) * g2;
    u16* ob = (u16*)(c.p.ws + OFF_OB);
#pragma unroll
    for (int dt = 0; dt < 8; ++dt) {
      const f32x4 tv = tsc[dt * 64] + st.o[dt] * inv;
      const int d = head * 128 + dt * 16 + fq * 4;
      const s16x4 z = *(const s16x4*)(proj + (size_t)tc * NP + C_BZ + d);
      f32x4 o;
#pragma unroll
      for (int r = 0; r < 4; ++r) o[r] = tv[r] * siluf_(bf2f_s(z[r]));
      *(s16x4*)(ob + (size_t)tc * 1024 + d) = pack4(o);
    }
  }
#if 0
  {
    {
    f32x4 o;
    *(s16x4*)(ob + (size_t)tc * 1024 + d) = pack4(o);
  }
  }
#endif
}

DI void phase_p3(const Ctx& c, char* smem) {
  for (int it = blockIdx.x; it < 512; it += gridDim.x) nsa_block_item(c, it, smem);
}

DI void phase_merge(const Ctx& c, u16* lds) {
  const int tid = otid(), lane = tid & 63, wave = tid >> 6, wm = wave >> 1, wn = wave & 1, fr = lane & 15, fq = lane >> 4;
  const u16* proj = (const u16*)(c.p.ws + OFF_PROJ);
  u16* mix = (u16*)(c.p.ws + OFF_MIX);
  constexpr int GS = 136;
  for (int it = blockIdx.x; it < 32 * 8; it += gridDim.x) {
    const int nt = it >> 5, mt = it & 31;
    s16x4 totp[4][4];
#pragma unroll 1
    for (int br = 0; br < 3; ++br) {
      const u16* A = (const u16*)(c.p.ws + (br == 0 ? OFF_OA : (br == 1 ? OFF_OB : OFF_OC)));
      const int K = (br == 1) ? 1024 : 512;
      const u16* Bt = (const u16*)(c.lw() + (br == 0 ? LW_WA : (br == 1 ? LW_WB : LW_WC)));
      f32x4 acc[4][4]; zero_acc<4>(acc);
      u32x4 gpre[8];
#pragma unroll
      for (int i = 0; i < 8; ++i) {
        const int cidx = tid + 512 * i, row = cidx >> 4, ch = cidx & 15;
        gpre[i] = *(const u32x4*)(proj + (size_t)(mt * 256 + row) * NP + C_MG + br * 1024 + nt * 128 + ch * 8);
      }
      gemm_mainloop_dma<4>(A + (size_t)mt * 256 * K, K, Bt + (size_t)nt * 128 * K, K, K, acc, lds);
#pragma unroll
      for (int i = 0; i < 8; ++i) {
        const int cidx = tid + 512 * i, row = cidx >> 4, ch = cidx & 15;
        *(u32x4*)(lds + row * GS + ch * 8) = gpre[i];
      }
      __syncthreads();
#pragma unroll
      for (int m = 0; m < 4; ++m)
#pragma unroll
        for (int n = 0; n < 4; ++n) {
          f32x4 t;
#pragma unroll
          for (int r = 0; r < 4; ++r) {
            const float gt = sigmoidf_(bf2f(lds[(wm * 64 + m * 16 + fq * 4 + r) * GS + wn * 64 + n * 16 + fr]));
            t[r] = gt * acc[m][n][r] + (br == 0 ? 0.f : bf2f_s(totp[m][n][r]));
          }
          totp[m][n] = pack4(t);
        }
    }
    __syncthreads();
#pragma unroll
    for (int m = 0; m < 4; ++m)
#pragma unroll
      for (int n = 0; n < 4; ++n)
#pragma unroll
        for (int r = 0; r < 4; ++r) lds[(wm * 64 + m * 16 + fq * 4 + r) * GS + wn * 64 + n * 16 + fr] = (u16)totp[m][n][r];
    __syncthreads();
#pragma unroll
    for (int i = 0; i < 8; ++i) {
      const int cidx = tid + 512 * i, row = cidx >> 4, ch = cidx & 15;
      *(u32x4*)(mix + (size_t)(mt * 256 + row) * 1024 + nt * 128 + ch * 8) = *(const u32x4*)(lds + row * GS + ch * 8);
    }
  }
}

DI void phase_out(const Ctx& c, u16* lds) {
  const int tid = otid(), lane = tid & 63, wave = tid >> 6, wm = wave >> 1, wn = wave & 1, fr = lane & 15, fq = lane >> 4;
  const u16* mix = (const u16*)(c.p.ws + OFF_MIX);
  const u16* wot = (const u16*)(c.lw() + LW_WO);
  const float* xin = (c.l == 0 ? c.p.x : c.p.out) + (size_t)c.b * S * DM;
  float* xout = c.p.out + (size_t)c.b * S * DM;
  float* sC = (float*)lds;
  constexpr int FS = 132;
  for (int it = blockIdx.x; it < 32 * 8; it += gridDim.x) {
    const int nt = it >> 5, mt = it & 31;
    f32x4 acc[4][4]; zero_acc<4>(acc);
    gemm_mainloop_dma<4>(mix + (size_t)mt * 256 * 1024, 1024, wot + (size_t)nt * 128 * 1024, 1024, 1024, acc, lds);
#pragma unroll
    for (int hf = 0; hf < 2; ++hf) {
      __syncthreads();
#pragma unroll
      for (int mm = 0; mm < 2; ++mm)
#pragma unroll
        for (int n = 0; n < 4; ++n)
#pragma unroll
          for (int r = 0; r < 4; ++r)
            sC[(wm * 32 + mm * 16 + fq * 4 + r) * FS + wn * 64 + n * 16 + fr] = acc[hf * 2 + mm][n][r];
      __syncthreads();
#pragma unroll
      for (int i = 0; i < 8; ++i) {
        const int cidx = tid + 512 * i, lr = cidx >> 5, c4 = cidx & 31;
        const int grow = mt * 256 + (lr >> 5) * 64 + (hf * 2 + ((lr >> 4) & 1)) * 16 + (lr & 15);
        const size_t idx = (size_t)grow * DM + nt * 128 + c4 * 4;
        const f32x4 xv = *(const f32x4*)(xin + idx);
        const f32x4 av = *(const f32x4*)(sC + lr * FS + c4 * 4);
        *(f32x4*)(xout + idx) = xv + av;
      }
    }
  }
}

DI void phase_final(const Params& p) {
  const int lane = otid() & 63;
  const int gw = (blockIdx.x * 512 + otid()) >> 6, nw = gridDim.x * 8;
  for (int row = gw; row < NBATCH * S; row += nw) {
    float* x = p.out + (size_t)row * DM;
    float4 v[4]; float ss = 0.f;
#pragma unroll
    for (int i = 0; i < 4; ++i) { v[i] = *(const float4*)(x + i * 256 + lane * 4); ss += v[i].x * v[i].x + v[i].y * v[i].y + v[i].z * v[i].z + v[i].w * v[i].w; }
    ss = wave_sum(ss);
    const float r = rsqrtf(ss * (1.f / 1024.f) + 1e-6f);
#pragma unroll
    for (int i = 0; i < 4; ++i) {
      const float4 g = *(const float4*)(p.fin_gain + i * 256 + lane * 4);
      float4 o; o.x = v[i].x * r * g.x; o.y = v[i].y * r * g.y; o.z = v[i].z * r * g.z; o.w = v[i].w * r * g.w;
      *(float4*)(x + i * 256 + lane * 4) = o;
    }
  }
}

constexpr int NPHASES = 2 + NBATCH * DEPTH * 7 + 1;

__global__ void __launch_bounds__(512, 2) mega(Params p, int ph_begin, int ph_end) {
  __shared__ __attribute__((aligned(16))) char smem[SM_TOTAL];
  cg::grid_group grid = cg::this_grid();
  if (threadIdx.x == 0) *(u32x4*)(smem + SM_BAR) = u32x4{0u, 0u, 0u, 0u};
  __syncthreads();
  const XcdBarrier xb = xcd_barrier_post((unsigned*)(p.ws + OFF_BAR), (volatile LAS unsigned*)(smem + SM_BAR));
  for (int ph = ph_begin; ph < ph_end; ++ph) {
#ifdef DUP_PH0
    if (ph == 0) phase_weights(p, (u16*)smem);
#endif
    if (ph == 0) phase_weights(p, (u16*)smem);
    else if (ph == 1) phase_memkv(p, (u16*)smem);
    else if (ph == NPHASES - 1) phase_final(p);
    else {
      const int q = ph - 2;
      Ctx c; c.p = p; c.b = q / (DEPTH * 7); c.l = (q / 7) % DEPTH;
      const int s = q % 7;

#ifdef DUP_S
      if (s == DUP_S) {
        if (s == 1) phase_proj(c, (u16*)smem);
        else if (s == 2) phase_p2(c, (u16*)smem);
        else if (s == 3) phase_p2b(c, (u16*)smem);
        else if (s == 4) phase_p3(c, smem);
        else if (s == 5) phase_merge(c, (u16*)smem);
      }
#endif
      if (s == 0) phase_norm(c);
      else if (s == 1) phase_proj(c, (u16*)smem);
      else if (s == 2) phase_p2(c, (u16*)smem);
      else if (s == 3) phase_p2b(c, (u16*)smem);
      else if (s == 4) phase_p3(c, smem);
      else if (s == 5) phase_merge(c, (u16*)smem);
      else phase_out(c, (u16*)smem);
    }
    if (ph + 1 < ph_end) { if (ph == 0) grid.sync(); else xcd_barrier(xb); }
  }
}

extern "C" void kernel_launch(void* const* d_in, const int* in_sizes, int n_in, void* d_out, int out_size, void* d_ws, size_t ws_size,
                              hipStream_t stream) {
  Params p{};
  p.x = (const float*)d_in[0]; p.mem = (const float*)d_in[1]; p.pos = (const int*)d_in[2];
  p.norm_gain = (const float*)d_in[3]; p.w_in = (const float*)d_in[4]; p.ln_g = (const float*)d_in[5]; p.ln_b = (const float*)d_in[6];
  p.w_sp = (const float*)d_in[7]; p.b_sp = (const float*)d_in[8];
  p.pe_k = (const float*)d_in[9]; p.w1_k = (const float*)d_in[10]; p.w2_k = (const float*)d_in[11];
  p.pe_v = (const float*)d_in[12]; p.w1_v = (const float*)d_in[13]; p.w2_v = (const float*)d_in[14];
  p.mem_gain = (const float*)d_in[15]; p.w_memkv = (const float*)d_in[16];
  p.w_a = (const float*)d_in[17]; p.w_b = (const float*)d_in[18]; p.w_c = (const float*)d_in[19]; p.w_out = (const float*)d_in[20];
  p.fin_gain = (const float*)d_in[21];
  p.out = (float*)d_out; p.ws = (char*)d_ws;
  static int grid_blocks = 0;
  if (!grid_blocks) {
    int dev = 0, cus = 0, per_cu = 0;
    hipGetDevice(&dev);
    hipDeviceGetAttribute(&cus, hipDeviceAttributeMultiprocessorCount, dev);
    hipOccupancyMaxActiveBlocksPerMultiprocessor(&per_cu, mega, 512, 0);
    if (per_cu > 1) per_cu = 1;
    if (per_cu < 1) per_cu = 1;
    grid_blocks = cus * per_cu;
  }
  hipMemsetAsync((char*)d_ws + OFF_BAR, 0, XCD_BAR_WORDS * 4, stream);
  int pb = 0, pe = NPHASES;
  void* args[] = {&p, &pb, &pe};
  hipError_t e = hipLaunchCooperativeKernel((void*)mega, dim3(grid_blocks), dim3(512), args, 0, stream);
  if (e != hipSuccess) fprintf(stderr, "cooperative launch failed: %s (grid %d)\n", hipGetErrorString(e), grid_blocks);
}
```
